# Optimizing an MI355X kernel written in HIP

```python
import math
import jax
import jax.numpy as jnp
from jax import lax

D_MODEL = 2048
BATCH = 8
SEQ = 2048
DEPTH = 1

GRID_W = 64
CTX_LEN = 256
EPS = 1e-6
N_MOD = 6

ATTN_WIDTH = D_MODEL // 2
ATTN_HEAD_DIM = 64
ATTN_VDIM = 2 * ATTN_HEAD_DIM
ATTN_HEADS = ATTN_WIDTH // ATTN_VDIM
ATTN_QK = ATTN_HEADS * 2 * ATTN_HEAD_DIM
Q_BLOCK = 128
ROPE_BASE = 10000.0

REC_WIDTH = D_MODEL // 2
REC_KDIM = 128
REC_VDIM = 128
REC_HEADS = REC_WIDTH // REC_VDIM
REC_K = REC_HEADS * REC_KDIM
REC_CHUNK = 64

FFN_DIM = 256 * ((8 * D_MODEL // 3 + 255) // 256)
CONV_W = 3

IN_SPLITS = (ATTN_QK, ATTN_WIDTH, REC_K, REC_K, REC_WIDTH,
             ATTN_QK, REC_K, REC_WIDTH, D_MODEL, D_MODEL)
CTX_KV_WIDTH = ATTN_QK + ATTN_WIDTH + 2 * REC_K + REC_WIDTH
IN_WIDTH = CTX_KV_WIDTH + ATTN_QK + REC_K + REC_WIDTH + 2 * D_MODEL

kernel_name = "hybrid_diffattn_hgrn2_convffn_dit"


def rms_norm(x, w):
    xf = x.astype(jnp.float32)
    y = xf * lax.rsqrt(jnp.mean(xf * xf, axis=-1, keepdims=True) + EPS)
    return y.astype(x.dtype) * w


def modulate(x, w, shift, scale):
    return rms_norm(x, w) * (1.0 + scale) + shift


def split_cols(z, n):
    out = []
    start = 0
    for width in IN_SPLITS[:n]:
        out.append(z[..., start:start + width])
        start += width
    return out


def to_qk_heads(a):
    return a.reshape(a.shape[0], a.shape[1], ATTN_HEADS, 2, ATTN_HEAD_DIM)


def to_v_heads(a):
    return a.reshape(a.shape[0], a.shape[1], ATTN_HEADS, ATTN_VDIM)


def to_rec_heads(a):
    return a.reshape(a.shape[0], a.shape[1], REC_HEADS, -1)


def axial_rope_tables(n_tokens, dtype):
    rows = n_tokens // GRID_W
    r, col = jnp.meshgrid(jnp.arange(rows), jnp.arange(GRID_W), indexing='ij')
    pos = jnp.stack([r.reshape(-1), col.reshape(-1)], axis=-1).astype(jnp.float32)
    nq = ATTN_HEAD_DIM // 4
    inv = ROPE_BASE ** (-jnp.arange(nq, dtype=jnp.float32) / nq)
    ang = pos[:, :, None] * inv
    return jnp.cos(ang).astype(dtype), jnp.sin(ang).astype(dtype)


def apply_axial_rope(x, cos, sin):
    B, S, H, C, d = x.shape
    xr = x.reshape(B, S, H, C, 2, 2, d // 4)
    x1, x2 = xr[..., 0, :], xr[..., 1, :]
    cs = cos[None, :, None, None]
    sn = sin[None, :, None, None]
    out = jnp.stack([x1 * cs - x2 * sn, x2 * cs + x1 * sn], axis=-2)
    return out.reshape(B, S, H, C, d)


def diff_attn_core(q, k, v, lam):
    s = jnp.einsum('bqhcd,bkhcd->bhcqk', q, k).astype(jnp.float32) * (ATTN_HEAD_DIM ** -0.5)
    p = jax.nn.softmax(s, axis=-1)
    a = p[:, :, 0] - lam * p[:, :, 1]
    return jnp.einsum('bhqk,bkhe->bqhe', a.astype(v.dtype), v)


def diff_attn_latent(q, k, v, lam):
    B, S, H, C, d = q.shape
    qb = q.reshape(B, S // Q_BLOCK, Q_BLOCK, H, C, d).transpose(1, 0, 2, 3, 4, 5)
    ob = lax.map(lambda blk: diff_attn_core(blk, k, v, lam), qb)
    return ob.transpose(1, 0, 2, 3, 4).reshape(B, S, H, v.shape[-1])


def diff_attn_readout(o, subln_w, lam_init):
    B, T = o.shape[0], o.shape[1]
    return (rms_norm(o, subln_w) * (1.0 - lam_init)).reshape(B, T, ATTN_WIDTH)


def rec_gate(f_raw, lower):
    f = lower + (1.0 - lower) * jax.nn.sigmoid(f_raw.astype(jnp.float32))
    return to_rec_heads(1.0 - f), to_rec_heads(jnp.log(f))


def gla_scan(q, k, v, logf, s0):
    B, T, H, _ = k.shape
    dv = v.shape[-1]
    nc = T // REC_CHUNK

    def chunks(a):
        return a.astype(jnp.float32).reshape(B, nc, REC_CHUNK, H, a.shape[-1]).transpose(1, 0, 3, 2, 4)

    mask = jnp.tril(jnp.ones((REC_CHUNK, REC_CHUNK), dtype=bool))[None, None, :, :, None]
    with_out = q is not None
    xs = (chunks(k), chunks(v), chunks(logf)) + ((chunks(q),) if with_out else ())

    def step(state, inp):
        kc, vc, gc = inp[0], inp[1], inp[2]
        b = jnp.cumsum(gc, axis=2)
        b_end = b[:, :, -1:, :]
        new_state = (jnp.exp(b_end)[:, :, 0, :, None] * state
                     + jnp.einsum('bhsk,bhsv->bhkv', kc * jnp.exp(b_end - b), vc))
        if not with_out:
            return new_state, None
        qc = inp[3]
        rel = jnp.exp(jnp.where(mask, b[:, :, :, None, :] - b[:, :, None, :, :], -jnp.inf))
        scores = jnp.einsum('bhtk,bhtsk,bhsk->bhts', qc, rel, kc)
        out = (jnp.einsum('bhts,bhsv->bhtv', scores, vc)
               + jnp.einsum('bhtk,bhkv->bhtv', qc * jnp.exp(b), state))
        return new_state, out

    state, out = lax.scan(step, s0.astype(jnp.float32), xs)
    if with_out:
        out = out.transpose(1, 0, 3, 2, 4).reshape(B, T, H, dv).astype(v.dtype)
    return state, out


def rec_direction(lat, ctx_feats, reverse):
    if reverse:
        flip = lambda a: None if a is None else jnp.flip(a, axis=1)
    else:
        flip = lambda a: a
    qc, kc, vc, gc = [flip(a) for a in ctx_feats]
    s0 = jnp.zeros((kc.shape[0], REC_HEADS, REC_KDIM, REC_VDIM), jnp.float32)
    s_ctx, o_ctx = gla_scan(qc, kc, vc, gc, s0)
    q, k, v, g = [flip(a) for a in lat]
    _, o_lat = gla_scan(q, k, v, g, s_ctx)
    return flip(o_lat), flip(o_ctx)


def rec_readout(o, g, w):
    B, T = o.shape[0], o.shape[1]
    return rms_norm(o.reshape(B, T, REC_WIDTH), w) * jax.nn.silu(g)


def merge_branches(att, rec, gate_a, gate_r, w_branch_attn, w_branch_rec, w_out):
    y = jax.nn.sigmoid(gate_a) * (att @ w_branch_attn) + jax.nn.sigmoid(gate_r) * (rec @ w_branch_rec)
    return y @ w_out


def conv_ffn(h, w_up, conv_w, conv_b, w_down):
    u = h @ w_up
    T = u.shape[1]
    pad = CONV_W // 2
    up = jnp.pad(u, ((0, 0), (pad, pad), (0, 0)))
    u = conv_b + sum(up[:, j:j + T] * conv_w[j] for j in range(CONV_W))
    a, b = jnp.split(u, 2, axis=-1)
    return (jax.nn.silu(a) * b) @ w_down


def hybrid_layer(x, ctx, mod, mod_c, lam, lam_init, lb_f, lb_b, norm1_w, w_in, subln_w, rec_gnorm_w,
                 w_branch_attn, w_branch_rec, w_out, norm2_w, w_up, conv_w, conv_b, w_down, ctx_out):
    B, S, _ = x.shape
    sh1, sc1, g1, sh2, sc2, g2 = jnp.split(mod[:, None, :], N_MOD, axis=-1)
    csh1, csc1, cg1, csh2, csc2, cg2 = jnp.split(mod_c, N_MOD, axis=-1)

    h = modulate(x, norm1_w, sh1, sc1)
    hc = modulate(ctx, norm1_w, csh1, csc1)
    ak, av, rff, rfb, ri, aq, rq, rg, gate_a, gate_r = split_cols(h @ w_in, len(IN_SPLITS))
    if ctx_out:
        akc, avc, rffc, rfbc, ric, aqc, rqc, rgc, gate_ac, gate_rc = split_cols(hc @ w_in, len(IN_SPLITS))
    else:
        akc, avc, rffc, rfbc, ric = split_cols(hc @ w_in[:, :CTX_KV_WIDTH], 5)

    cos, sin = axial_rope_tables(S, x.dtype)
    k_all = jnp.concatenate([apply_axial_rope(to_qk_heads(ak), cos, sin), to_qk_heads(akc)], axis=1)
    v_all = jnp.concatenate([to_v_heads(av), to_v_heads(avc)], axis=1)
    o_att = diff_attn_latent(apply_axial_rope(to_qk_heads(aq), cos, sin), k_all, v_all, lam)
    att = diff_attn_readout(o_att, subln_w, lam_init)

    v_r, vc_r = to_rec_heads(ri), to_rec_heads(ric)
    q_r = to_rec_heads(jax.nn.silu(rq))
    qc_r = to_rec_heads(jax.nn.silu(rqc)) if ctx_out else None
    kf, logf_f = rec_gate(rff, lb_f)
    kb, logf_b = rec_gate(rfb, lb_b)
    kfc, logfc_f = rec_gate(rffc, lb_f)
    kbc, logfc_b = rec_gate(rfbc, lb_b)
    o_f, oc_f = rec_direction((q_r, kf, v_r, logf_f), (qc_r, kfc, vc_r, logfc_f), False)
    o_b, oc_b = rec_direction((q_r, kb, v_r, logf_b), (qc_r, kbc, vc_r, logfc_b), True)
    rec = rec_readout(o_f + o_b, rg, rec_gnorm_w)

    x = x + g1 * merge_branches(att, rec, gate_a, gate_r, w_branch_attn, w_branch_rec, w_out)
    x = x + g2 * conv_ffn(modulate(x, norm2_w, sh2, sc2), w_up, conv_w, conv_b, w_down)

    if ctx_out:
        oc_att = diff_attn_core(to_qk_heads(aqc), to_qk_heads(akc), to_v_heads(avc), lam)
        att_c = diff_attn_readout(oc_att, subln_w, lam_init)
        rec_c = rec_readout(oc_f + oc_b, rgc, rec_gnorm_w)
        ctx = ctx + cg1 * merge_branches(att_c, rec_c, gate_ac, gate_rc, w_branch_attn, w_branch_rec, w_out)
        ctx = ctx + cg2 * conv_ffn(modulate(ctx, norm2_w, csh2, csc2), w_up, conv_w, conv_b, w_down)
    return x, ctx


def setup_inputs(seed: int = 0) -> dict:
    key = jax.random.key(seed)
    ks = jax.random.split(key, 24)
    f32 = jnp.float32

    def nrm(k, shape, fan_in):
        return jax.random.normal(k, shape, f32) * fan_in ** -0.5

    def gain(k, shape):
        return 1.0 + 0.02 * jax.random.normal(k, shape, f32)

    def small(k, shape, s):
        return s * jax.random.normal(k, shape, f32)

    return {
        "x": jax.random.normal(ks[0], (BATCH, SEQ, D_MODEL), f32),
        "c": jax.random.normal(ks[1], (BATCH, D_MODEL), f32),
        "ctx": jax.random.normal(ks[2], (BATCH, CTX_LEN, D_MODEL), f32),
        "c_ctx": jax.random.normal(ks[3], (D_MODEL,), f32),
        "w_mod": nrm(ks[4], (DEPTH, D_MODEL, N_MOD * D_MODEL), D_MODEL),
        "b_mod": small(ks[5], (DEPTH, N_MOD * D_MODEL), 0.02),
        "norm1_w": gain(ks[6], (DEPTH, D_MODEL)),
        "w_in": nrm(ks[7], (DEPTH, D_MODEL, IN_WIDTH), D_MODEL),
        "lam_q1": small(ks[8], (DEPTH, ATTN_HEAD_DIM), 0.1),
        "lam_k1": small(ks[9], (DEPTH, ATTN_HEAD_DIM), 0.1),
        "lam_q2": small(ks[10], (DEPTH, ATTN_HEAD_DIM), 0.1),
        "lam_k2": small(ks[11], (DEPTH, ATTN_HEAD_DIM), 0.1),
        "subln_w": gain(ks[12], (DEPTH, ATTN_VDIM)),
        "rec_lb": small(ks[13], (2, DEPTH + 1, REC_K), 0.5),
        "rec_gnorm_w": gain(ks[14], (DEPTH, REC_WIDTH)),
        "w_branch_attn": nrm(ks[15], (DEPTH, ATTN_WIDTH, D_MODEL), ATTN_WIDTH),
        "w_branch_rec": nrm(ks[16], (DEPTH, REC_WIDTH, D_MODEL), REC_WIDTH),
        "w_out": nrm(ks[17], (DEPTH, D_MODEL, D_MODEL), D_MODEL),
        "norm2_w": gain(ks[18], (DEPTH, D_MODEL)),
        "w_up": nrm(ks[19], (DEPTH, D_MODEL, 2 * FFN_DIM), D_MODEL),
        "conv_w": nrm(ks[20], (DEPTH, CONV_W, 2 * FFN_DIM), CONV_W),
        "conv_b": small(ks[21], (DEPTH, 2 * FFN_DIM), 0.02),
        "w_down": nrm(ks[22], (DEPTH, FFN_DIM, D_MODEL), FFN_DIM),
        "final_norm_w": gain(ks[23], (D_MODEL,)),
    }


def reference(x, c, ctx, c_ctx, w_mod, b_mod, norm1_w, w_in, lam_q1, lam_k1, lam_q2, lam_k2, subln_w,
              rec_lb, rec_gnorm_w, w_branch_attn, w_branch_rec, w_out, norm2_w, w_up, conv_w, conv_b,
              w_down, final_norm_w):
    lower = jnp.cumsum(jax.nn.softmax(rec_lb.astype(jnp.float32), axis=1), axis=1)
    for l in range(DEPTH):
        mod = jax.nn.silu(c) @ w_mod[l] + b_mod[l]
        mod_c = jax.nn.silu(c_ctx) @ w_mod[l] + b_mod[l]
        lam_init = 0.8 - 0.6 * math.exp(-0.3 * l)
        lam = (jnp.exp(jnp.sum(lam_q1[l].astype(jnp.float32) * lam_k1[l].astype(jnp.float32)))
               - jnp.exp(jnp.sum(lam_q2[l].astype(jnp.float32) * lam_k2[l].astype(jnp.float32)))
               + lam_init)
        x, ctx = hybrid_layer(x, ctx, mod, mod_c, lam, lam_init, lower[0, l], lower[1, l],
                              norm1_w[l], w_in[l], subln_w[l], rec_gnorm_w[l],
                              w_branch_attn[l], w_branch_rec[l], w_out[l], norm2_w[l],
                              w_up[l], conv_w[l], conv_b[l], w_down[l], l < DEPTH - 1)
    return rms_norm(x, final_norm_w)
```

```cpp
#include <hip/hip_runtime.h>
#include <hip/hip_cooperative_groups.h>
#include <cstdio>
#include <cstdint>
namespace cg = cooperative_groups;
#define DI __device__ __forceinline__
#define LAS __attribute__((address_space(3)))
typedef unsigned short u16;
typedef float f32x2 __attribute__((ext_vector_type(2)));
typedef float f32x4v __attribute__((ext_vector_type(4)));
typedef float f32x16 __attribute__((ext_vector_type(16)));
typedef short s16x8 __attribute__((ext_vector_type(8)));
typedef short s16x4 __attribute__((ext_vector_type(4)));
typedef unsigned u32x4v __attribute__((ext_vector_type(4)));
typedef unsigned u32x2v __attribute__((ext_vector_type(2)));
typedef __bf16 bf16x2_t __attribute__((ext_vector_type(2)));
typedef _Float16 h16x2_t __attribute__((ext_vector_type(2)));

constexpr int DM = 2048, NB = 8, SEQ = 2048, MTOK = NB * SEQ, CTXL = 256, MCTX = NB * CTXL, MALL = MTOK + MCTX;
constexpr int NIN = 12288, TKV = SEQ + CTXL  , FF = 5632, FF2 = 2 * FF;
constexpr float EPS = 1e-6f;
constexpr size_t MiB = 1u << 20;
constexpr size_t WS_CTL = 0, WS_WUP = 2 * MiB, WS_WDN = 46 * MiB, WS_SIDE = 68 * MiB, WS_H2 = 91 * MiB, WS_U = 155 * MiB, WS_END = 507 * MiB;
constexpr size_t WS_WIN = 68 * MiB, WS_WBA = 116 * MiB, WS_WBR = 120 * MiB, WS_WOUT = 124 * MiB, WS_H = 132 * MiB, WS_OF = 132 * MiB, WS_OB = 164 * MiB;
constexpr size_t WS_AK = 204 * MiB, WS_AV = 240 * MiB, WS_LFF = 276 * MiB, WS_LFB = 312 * MiB, WS_RI = 348 * MiB, WS_RQ = 384 * MiB, WS_AQ = 416 * MiB, WS_RG = 448 * MiB;
constexpr size_t WS_T = 204 * MiB, WS_Y = 348 * MiB, WS_ATT = 68 * MiB;
constexpr int C_MOD = 0, C_LAM = 110592, C_LBF = 110608, C_LBB = 111632, C_COS = 112656, C_SIN = 113680, C_CTR = 114704;
constexpr size_t CTL_ZERO_BYTES = 1 * MiB;
constexpr int LDS_BYTES = 147456, XB_LDS_OFF = LDS_BYTES - 64;
constexpr int C_CNTP = 135168;
constexpr size_t WS_PART = 76 * MiB;
constexpr int C_BAR = 131072;

DI unsigned cvtpk(float lo, float hi) { f32x2 v = {lo, hi}; bf16x2_t b = __builtin_convertvector(v, bf16x2_t); return __builtin_bit_cast(unsigned, b); }
DI unsigned cvtpk_h(float lo, float hi) { f32x2 v = {lo, hi}; h16x2_t b = __builtin_convertvector(v, h16x2_t); return __builtin_bit_cast(unsigned, b); }
DI float bf2f(u16 b) { return __uint_as_float((unsigned)b << 16); }
DI float bflo(unsigned w) { return __uint_as_float(w << 16); }
DI float bfhi(unsigned w) { return __uint_as_float(w & 0xffff0000u); }
DI u16 f2bf(float f) { return (u16)(cvtpk(f, 0.f) & 0xffffu); }
DI float h2f(u16 h) { return (float)__builtin_bit_cast(_Float16, h); }
DI float fexp(float x) { return __builtin_amdgcn_exp2f(x * 1.4426950408889634f); }
DI float sigm(float x) { return __builtin_amdgcn_rcpf(1.f + fexp(-x)); }
DI float silu_(float x) { return x * sigm(x); }
DI float wave_sum(float v) {
#pragma unroll
  for (int o = 1; o < 64; o <<= 1) v += __shfl_xor(v, o);
  return v;
}
#define LDS_WAIT() asm volatile("s_waitcnt lgkmcnt(0)" ::: "memory")

namespace pg8 {
#define PG8_LAS __attribute__((address_space(3)))
typedef unsigned short bf16_t;
typedef short bf16x8 __attribute__((ext_vector_type(8)));
typedef float f32x4 __attribute__((ext_vector_type(4)));
typedef unsigned u32x4 __attribute__((ext_vector_type(4)));
constexpr int BM = 256, BK = 64, HALF = 128, HTB = HALF * BK * 2  , STAGE_BYTES = 8 * HTB, NXCD = 8, WGM = 4;

__host__ __device__ __forceinline__ int lds_byte(int r, int c) { const int st = (r >> 4) * 2 + (c >> 5), rr = r & 15, cc = c & 31, ob = rr * 64 + cc * 2; return st * 1024 + (ob ^ (((ob >> 9) & 1) << 5)); }
__host__ __device__ __forceinline__ void stage_rc(int b, int& R, int& C) { const int st = b / 1024, sb = b % 1024, swz = sb ^ (((sb >> 9) & 1) << 5); R = (st >> 1) * 16 + swz / 64; C = (st & 1) * 32 + (swz % 64) / 2; }
__host__ __device__ __forceinline__ int perm32(int rho) { const int n = rho >> 4, i = rho & 15; return 8 * (i >> 2) + 4 * n + (i & 3); }

struct Unit { int pm, pn; };
struct Gemm { const bf16_t* A; const bf16_t* Bt; int M, N, K, lda; };

struct StaticOrder {
    int nM, nN, nwg, G, c;
    __host__ __device__ void init(int M, int N, int G_, int c_) { nM = M / BM; nN = N / BM; nwg = nM * nN; G = G_; c = c_; }
    __host__ __device__ bool next(int i, Unit& u) const {
        const long L = (long)i * G + c; if (L >= nwg) return false;
        int wgid = (int)L; { const int q = nwg / NXCD, r = nwg % NXCD, xcd = wgid % NXCD, off = wgid / NXCD; wgid = (xcd < r ? xcd * (q + 1) : r * (q + 1) + (xcd - r) * q) + off; }
        const int nig = WGM * nN, gid = wgid / nig, fm = gid * WGM, gsz = (nM - fm) < WGM ? (nM - fm) : WGM;
        u.pm = fm + ((wgid % nig) % gsz); u.pn = (wgid % nig) / gsz; return true;
    }
    __device__ __forceinline__ void a_ready(const Unit&) const {}
    __device__ __forceinline__ void done(const Unit&) const {}
};
typedef PG8_LAS unsigned char* LdsPtr;
__device__ __forceinline__ unsigned cvt_pk_bf16(float lo, float hi) { return cvtpk(lo, hi); }
template <class Epi, class Sched, bool ALIGN_EPI = false, bool SP2 = false>
__device__ __forceinline__ void gemm_phase(PG8_LAS unsigned char* lds, const Gemm g, const Sched& S, const Epi& E) {
    int tid_ = threadIdx.x; asm volatile("" : "+v"(tid_)); const int tid = tid_, wid = __builtin_amdgcn_readfirstlane(tid >> 6), lane = tid & 63, wr = wid >> 2, wc = wid & 3, fr = lane & 15, fq = lane >> 4;
    const int K = g.K, nt = K / BK;
    unsigned voffA[2], voffB[2];
#pragma unroll
    for (int i = 0; i < 2; ++i) { int R, C; stage_rc(tid * 16 + i * 8192, R, C); const int Rb = Epi::PERM ? ((R & ~31) + perm32(R & 31)) : R;
        voffA[i] = (unsigned)(R * g.lda + C) * 2u; voffB[i] = (unsigned)(Rb * K + C) * 2u; }
    const size_t kstep = (size_t)(BK * 2);
    const size_t hstepA = (size_t)HALF * g.lda * 2, hstepB = (size_t)HALF * K * 2;
    const size_t tstepA = 2 * hstepA, tstepB = 2 * hstepB;
    const unsigned ldsw = (unsigned)wid * 1024u;
    const int aoff = lds_byte(wr * 64 + fr, fq * 8), boff = lds_byte(wc * 32 + fr, fq * 8);
#define PG8_SA(b, h) (((b) * 2 + (h)) * HTB)
#define PG8_SB(b, h) ((4 + (b) * 2 + (h)) * HTB)
#define PG8_STAGE(bufoff, gbase, voff) do { _Pragma("unroll") for (int _i = 0; _i < 2; ++_i) \
        __builtin_amdgcn_global_load_lds((const unsigned*)((const char*)(gbase) + (voff)[_i]), (PG8_LAS unsigned*)(lds + (bufoff) + ldsw + _i * 8192), 16, 0, 0); } while (0)
#define PG8_LDA(dst, b, h) do { _Pragma("unroll") for (int m = 0; m < 4; ++m) _Pragma("unroll") for (int k = 0; k < 2; ++k) dst[m][k] = *(const PG8_LAS bf16x8*)(lds + PG8_SA(b, h) + aoff + m * 2048 + k * 1024); } while (0)
#define PG8_LDB(dst, b, h) do { _Pragma("unroll") for (int n = 0; n < 2; ++n) _Pragma("unroll") for (int k = 0; k < 2; ++k) dst[n][k] = *(const PG8_LAS bf16x8*)(lds + PG8_SB(b, h) + boff + n * 2048 + k * 1024); } while (0)
#define PG8_MMA(ai, bj, At, Bt) do { __builtin_amdgcn_s_setprio(1); _Pragma("unroll") for (int m = 0; m < 4; ++m) _Pragma("unroll") for (int n = 0; n < 2; ++n) _Pragma("unroll") for (int k = 0; k < 2; ++k) \
        acc[ai][bj][m][n] = __builtin_amdgcn_mfma_f32_16x16x32_bf16(Bt[n][k], At[m][k], acc[ai][bj][m][n], 0, 0, 0); __builtin_amdgcn_s_setprio(0); } while (0)
#define PG8_WAIT_V(n) asm volatile("s_waitcnt vmcnt(" #n ")" ::: "memory")
#define PG8_WAIT_L(n) asm volatile("s_waitcnt lgkmcnt(" #n ")" ::: "memory")
#define PG8_BAR __builtin_amdgcn_s_barrier()
#define PG8_SCHED __builtin_amdgcn_sched_barrier(0)
    Unit cur, nxt; int ui = 0;
    if (!S.next(0, cur)) return;
    f32x4 acc[2][2][4][2];
#pragma unroll
    for (int a = 0; a < 2; ++a)
#pragma unroll
        for (int b = 0; b < 2; ++b)
#pragma unroll
            for (int m = 0; m < 4; ++m)
#pragma unroll
                for (int n = 0; n < 2; ++n) acc[a][b][m][n] = (f32x4){0.f, 0.f, 0.f, 0.f};
    bf16x8 At[4][2], B0[2][2], B1[2][2];
    const char* cA = (const char*)g.A + (size_t)cur.pm * tstepA; const char* cB = (const char*)g.Bt + (size_t)cur.pn * tstepB;
    S.a_ready(cur);
    if constexpr (SP2) {
        PG8_STAGE(PG8_SB(0, 0), cB, voffB); PG8_STAGE(PG8_SB(0, 1), cB + hstepB, voffB); PG8_STAGE(PG8_SA(0, 0), cA, voffA); PG8_STAGE(PG8_SA(0, 1), cA + hstepA, voffA);
        if (wr == 1) PG8_BAR;
        PG8_WAIT_V(2); PG8_BAR;
        PG8_STAGE(PG8_SB(1, 0), cB + kstep, voffB); PG8_STAGE(PG8_SA(1, 0), cA + kstep, voffA); PG8_STAGE(PG8_SB(1, 1), cB + hstepB + kstep, voffB);
        PG8_WAIT_V(6); PG8_BAR;
    } else {
        PG8_STAGE(PG8_SB(0, 0), cB, voffB); PG8_STAGE(PG8_SA(0, 0), cA, voffA); PG8_STAGE(PG8_SB(0, 1), cB + hstepB, voffB); PG8_STAGE(PG8_SA(0, 1), cA + hstepA, voffA);
        if (wr == 1) PG8_BAR;
        PG8_WAIT_V(4); PG8_BAR;
        PG8_STAGE(PG8_SB(1, 0), cB + kstep, voffB); PG8_STAGE(PG8_SA(1, 0), cA + kstep, voffA); PG8_STAGE(PG8_SB(1, 1), cB + hstepB + kstep, voffB);
        PG8_WAIT_V(6); PG8_BAR;
    }
    for (;;) {
        const bool has_next = S.next(ui + 1, nxt);
        const char* nA = has_next ? (const char*)g.A + (size_t)nxt.pm * tstepA : cA; const char* nB = has_next ? (const char*)g.Bt + (size_t)nxt.pn * tstepB : cB;
        for (int t = 0; t < nt; t += 2) {
            const bool last = (t == nt - 2);
            const char* a1 = cA + (size_t)(t + 1) * kstep;
            const char* a2 = last ? nA : cA + (size_t)(t + 2) * kstep; const char* b2 = last ? nB : cB + (size_t)(t + 2) * kstep;
            const char* a3 = a2 + kstep; const char* b3 = b2 + kstep;
            if (last && has_next) S.a_ready(nxt);
            if constexpr (SP2) {
            PG8_LDB(B0, 0, 0); PG8_LDB(B1, 0, 1); PG8_SCHED; PG8_LDA(At, 0, 0); PG8_STAGE(PG8_SA(1, 1), a1 + hstepA, voffA);
            PG8_WAIT_V(8); PG8_WAIT_L(0); PG8_BAR; PG8_MMA(0, 0, At, B0); PG8_MMA(0, 1, At, B1); PG8_BAR; PG8_SCHED;
            PG8_LDA(At, 0, 1); PG8_STAGE(PG8_SB(0, 0), b2, voffB); PG8_STAGE(PG8_SB(0, 1), b2 + hstepB, voffB); PG8_STAGE(PG8_SA(0, 0), a2, voffA);
            PG8_WAIT_V(8); PG8_WAIT_L(0); PG8_BAR; PG8_MMA(1, 0, At, B0); PG8_MMA(1, 1, At, B1); PG8_BAR; PG8_SCHED;
            PG8_LDB(B0, 1, 0); PG8_LDB(B1, 1, 1); PG8_SCHED; PG8_LDA(At, 1, 0); PG8_STAGE(PG8_SA(0, 1), a2 + hstepA, voffA);
            PG8_WAIT_V(8); PG8_WAIT_L(0); PG8_BAR; PG8_MMA(0, 0, At, B0); PG8_MMA(0, 1, At, B1); PG8_BAR; PG8_SCHED;
            PG8_LDA(At, 1, 1); PG8_STAGE(PG8_SB(1, 0), b3, voffB); PG8_STAGE(PG8_SB(1, 1), b3 + hstepB, voffB); PG8_STAGE(PG8_SA(1, 0), a3, voffA);
            PG8_WAIT_V(8); PG8_WAIT_L(0); PG8_BAR; PG8_MMA(1, 0, At, B0); PG8_MMA(1, 1, At, B1); PG8_BAR; PG8_SCHED;
            } else {
            PG8_LDB(B0, 0, 0); PG8_SCHED; PG8_LDA(At, 0, 0); PG8_STAGE(PG8_SA(1, 1), a1 + hstepA, voffA);
            PG8_WAIT_L(8); PG8_BAR; PG8_WAIT_L(0); PG8_MMA(0, 0, At, B0); PG8_BAR; PG8_SCHED;
            PG8_LDB(B1, 0, 1); PG8_STAGE(PG8_SB(0, 0), b2, voffB);
            PG8_BAR; PG8_WAIT_L(0); PG8_MMA(0, 1, At, B1); PG8_BAR;
            PG8_LDA(At, 0, 1); PG8_STAGE(PG8_SA(0, 0), a2, voffA);
            PG8_BAR; PG8_WAIT_L(0); PG8_MMA(1, 0, At, B0); PG8_BAR; PG8_SCHED;
            PG8_STAGE(PG8_SB(0, 1), b2 + hstepB, voffB);
            PG8_WAIT_V(6); PG8_BAR; PG8_MMA(1, 1, At, B1); PG8_BAR;
            PG8_LDB(B0, 1, 0); PG8_SCHED; PG8_LDA(At, 1, 0); PG8_STAGE(PG8_SA(0, 1), a2 + hstepA, voffA);
            PG8_WAIT_L(8); PG8_BAR; PG8_WAIT_L(0); PG8_MMA(0, 0, At, B0); PG8_BAR; PG8_SCHED;
            PG8_LDB(B1, 1, 1); PG8_STAGE(PG8_SB(1, 0), b3, voffB);
            PG8_BAR; PG8_WAIT_L(0); PG8_MMA(0, 1, At, B1); PG8_BAR;
            PG8_LDA(At, 1, 1); PG8_STAGE(PG8_SA(1, 0), a3, voffA);
            PG8_BAR; PG8_WAIT_L(0); PG8_MMA(1, 0, At, B0); PG8_BAR; PG8_SCHED;
            PG8_STAGE(PG8_SB(1, 1), b3 + hstepB, voffB);
            PG8_WAIT_V(6); PG8_BAR; PG8_MMA(1, 1, At, B1); PG8_BAR;
            }
        }
        if constexpr (ALIGN_EPI) { if (wr == 0) PG8_BAR; }
        if constexpr (!Epi::AFTER_DRAIN) { E(acc, cur, wr, wc, fr, fq); S.done(cur); }
        if (!has_next) break;
#pragma unroll
        for (int a = 0; a < 2; ++a)
#pragma unroll
            for (int b = 0; b < 2; ++b)
#pragma unroll
                for (int m = 0; m < 4; ++m)
#pragma unroll
                    for (int n = 0; n < 2; ++n) acc[a][b][m][n] = (f32x4){0.f, 0.f, 0.f, 0.f};
        cur = nxt; cA = nA; cB = nB; ++ui;
        if constexpr (ALIGN_EPI) { if (wr == 1) PG8_BAR; }
    }
    PG8_WAIT_V(0);
    if constexpr (!ALIGN_EPI) { if (wr == 0) PG8_BAR; }
    PG8_BAR;
    if constexpr (Epi::AFTER_DRAIN) { E.fused(acc, cur, wr, wc, fr, fq, lds, wid, lane); S.done(cur); }
#undef PG8_SA
#undef PG8_SB
#undef PG8_STAGE
#undef PG8_LDA
#undef PG8_LDB
#undef PG8_MMA
#undef PG8_WAIT_V
#undef PG8_WAIT_L
#undef PG8_BAR
#undef PG8_SCHED
}
struct OrderIn {
    StaticOrder so; int G, c;
    __device__ void init(int G_, int c_) { so.init(16384, 12288, G_, c_); G = G_; c = c_; }
    __device__ bool next(int i, Unit& u) const {
        if (so.next(i, u)) return true;
        const long L = (long)i * G + c - 3072; if (L < 0 || L >= 160) return false;
        u.pm = 64 + (int)(L & 7); u.pn = (int)(L >> 3); return true;
    }
    __device__ __forceinline__ void a_ready(const Unit&) const {}
    __device__ __forceinline__ void done(const Unit&) const {}
};

struct EpiIn {
    static constexpr bool PERM = true, AFTER_DRAIN = false;
    u16 *AK, *AV, *LFF, *LFB, *RI, *AQ, *RQ, *RG, *GATES; const float *lbf, *lbb, *rcos, *rsin;
    template <int MODE> __device__ __forceinline__ void run(const f32x4 (&acc)[2][2][4][2], u16* dst, int ld, int row0, int col0, int trow0, int wc, int fq, const float* lb) const {
        f32x4 lb0[2], lb1[2];
        if (MODE == 3) {
#pragma unroll
            for (int bj = 0; bj < 2; ++bj) { lb0[bj] = *(const f32x4*)(lb + col0 + bj * HALF); lb1[bj] = *(const f32x4*)(lb + col0 + bj * HALF + 4); }
        }
#pragma unroll
        for (int ai = 0; ai < 2; ++ai)
#pragma unroll
            for (int m = 0; m < 4; ++m) {
                const int rr = ai * HALF + m * 16;
                u16* rowp = dst + (size_t)(row0 + rr) * ld + col0;
                f32x4 cs, sn;
                if (MODE == 1 || MODE == 2) { const int t = trow0 + rr; const int pos = (wc & 1) ? (t & 63) : (t >> 6);
                    cs = *(const f32x4*)(rcos + pos * 16 + 4 * fq); sn = *(const f32x4*)(rsin + pos * 16 + 4 * fq); }
#pragma unroll
                for (int bj = 0; bj < 2; ++bj) {
                    f32x4 v0 = acc[ai][bj][m][0], v1 = acc[ai][bj][m][1];
                    if (MODE == 1 || MODE == 2) { const f32x4 a = v0 * cs - v1 * sn, b = v1 * cs + v0 * sn; v0 = a; v1 = b;
                        if (MODE == 2) { v0 = v0 * 0.18033688011112042f; v1 = v1 * 0.18033688011112042f; } }
                    if (MODE == 3) {
#pragma unroll
                        for (int i = 0; i < 4; ++i) { const float l0 = lb0[bj][i], l1 = lb1[bj][i];
                            v0[i] = __logf(l0 + (1.f - l0) * sigm(v0[i])); v1[i] = __logf(l1 + (1.f - l1) * sigm(v1[i])); }
                    }
                    if (MODE == 4) {
#pragma unroll
                        for (int i = 0; i < 4; ++i) { v0[i] = silu_(v0[i]); v1[i] = silu_(v1[i]); }
                    }
                    if (MODE == 5) {
#pragma unroll
                        for (int i = 0; i < 4; ++i) { v0[i] = sigm(v0[i]); v1[i] = sigm(v1[i]); }
                    }
                    u32x4 w;
                    if (MODE == 3) { w.x = cvtpk_h(v0[0], v0[1]); w.y = cvtpk_h(v0[2], v0[3]); w.z = cvtpk_h(v1[0], v1[1]); w.w = cvtpk_h(v1[2], v1[3]); }
                    else { w.x = cvtpk(v0[0], v0[1]); w.y = cvtpk(v0[2], v0[3]); w.z = cvtpk(v1[0], v1[1]); w.w = cvtpk(v1[2], v1[3]); }
                    *(u32x4*)(rowp + bj * HALF) = w;
                }
            }
    }
    __device__ __forceinline__ void operator()(const f32x4 (&acc)[2][2][4][2], const Unit& u, int wr, int wc, int fr, int fq) const {
        const int pm = u.pm, pn = u.pn; const bool ctx = pm >= 64;
        const int b = ctx ? pm - 64 : (pm >> 3);
        const int trow0 = (ctx ? 0 : (pm & 7) * 256) + wr * 64 + fr;
        const int kvrow0 = b * TKV + (ctx ? SEQ : 0) + trow0;
        const int latrow0 = pm * 256 + wr * 64 + fr;
        const int seg = pn >> 2, c1 = (pn & 3) * 256 + wc * 32 + 8 * fq;
        switch (seg) {
        case 0: if (ctx) run<0>(acc, AK, 1024, kvrow0, c1, trow0, wc, fq, nullptr); else run<1>(acc, AK, 1024, kvrow0, c1, trow0, wc, fq, nullptr); break;
        case 1: run<0>(acc, AV, 1024, kvrow0, c1, trow0, wc, fq, nullptr); break;
        case 2: run<3>(acc, LFF, 1024, kvrow0, c1, trow0, wc, fq, lbf); break;
        case 3: run<3>(acc, LFB, 1024, kvrow0, c1, trow0, wc, fq, lbb); break;
        case 4: run<0>(acc, RI, 1024, kvrow0, c1, trow0, wc, fq, nullptr); break;
        case 5: run<2>(acc, AQ, 1024, latrow0, c1, trow0, wc, fq, nullptr); break;
        case 6: run<4>(acc, RQ, 1024, latrow0, c1, trow0, wc, fq, nullptr); break;
        case 7: run<4>(acc, RG, 1024, latrow0, c1, trow0, wc, fq, nullptr); break;
        default: run<5>(acc, GATES, 4096, latrow0, (pn - 32) * 256 + wc * 32 + 8 * fq, trow0, wc, fq, nullptr); break;
        }
    }
};
struct EpiMergeA {
    static constexpr bool PERM = true, AFTER_DRAIN = false;
    const u16* GATES; u16* T;
    __device__ __forceinline__ void operator()(const f32x4 (&acc)[2][2][4][2], const Unit& u, int wr, int wc, int fr, int fq) const {
        const int row0 = u.pm * BM + wr * 64 + fr, col0 = u.pn * BM + wc * 32 + 8 * fq;
#pragma unroll
        for (int ai = 0; ai < 2; ++ai)
#pragma unroll
            for (int m = 0; m < 4; ++m) { const size_t r = (size_t)(row0 + ai * HALF + m * 16);
#pragma unroll
                for (int bj = 0; bj < 2; ++bj) { const int c = col0 + bj * HALF;
                    const u32x4 g = *(const u32x4*)(GATES + r * 4096 + c);
                    const f32x4 v0 = acc[ai][bj][m][0], v1 = acc[ai][bj][m][1];
                    u32x4 w; w.x = cvtpk(v0[0] * bflo(g.x), v0[1] * bfhi(g.x)); w.y = cvtpk(v0[2] * bflo(g.y), v0[3] * bfhi(g.y));
                    w.z = cvtpk(v1[0] * bflo(g.z), v1[1] * bfhi(g.z)); w.w = cvtpk(v1[2] * bflo(g.w), v1[3] * bfhi(g.w));
                    *(u32x4*)(T + r * 2048 + c) = w; } }
    }
};
struct EpiMergeB {
    static constexpr bool PERM = true, AFTER_DRAIN = false;
    const u16* GATES; const u16* T; u16* Y;
    __device__ __forceinline__ void operator()(const f32x4 (&acc)[2][2][4][2], const Unit& u, int wr, int wc, int fr, int fq) const {
        const int row0 = u.pm * BM + wr * 64 + fr, col0 = u.pn * BM + wc * 32 + 8 * fq;
#pragma unroll
        for (int ai = 0; ai < 2; ++ai)
#pragma unroll
            for (int m = 0; m < 4; ++m) { const size_t r = (size_t)(row0 + ai * HALF + m * 16);
#pragma unroll
                for (int bj = 0; bj < 2; ++bj) { const int c = col0 + bj * HALF;
                    const u32x4 g = *(const u32x4*)(GATES + r * 4096 + 2048 + c);
                    const u32x4 t = *(const u32x4*)(T + r * 2048 + c);
                    const f32x4 v0 = acc[ai][bj][m][0], v1 = acc[ai][bj][m][1];
                    u32x4 w; w.x = cvtpk(bflo(t.x) + v0[0] * bflo(g.x), bfhi(t.x) + v0[1] * bfhi(g.x)); w.y = cvtpk(bflo(t.y) + v0[2] * bflo(g.y), bfhi(t.y) + v0[3] * bfhi(g.y));
                    w.z = cvtpk(bflo(t.z) + v1[0] * bflo(g.z), bfhi(t.z) + v1[1] * bfhi(g.z)); w.w = cvtpk(bflo(t.w) + v1[2] * bflo(g.w), bfhi(t.w) + v1[3] * bfhi(g.w));
                    *(u32x4*)(Y + r * 2048 + c) = w; } }
    }
};
struct EpiRes {
    static constexpr bool PERM = false, AFTER_DRAIN = false;
    const float* base; float* out; const float* gate;
    __device__ __forceinline__ void operator()(const f32x4 (&acc)[2][2][4][2], const Unit& u, int wr, int wc, int fr, int fq) const {
        const int row0 = u.pm * BM + wr * 64 + fr, col0 = u.pn * BM + wc * 32 + 4 * fq;
        const float* gb = gate + (size_t)(u.pm >> 3) * NIN;
        f32x4 gv[2][2];
#pragma unroll
        for (int bj = 0; bj < 2; ++bj)
#pragma unroll
            for (int n = 0; n < 2; ++n) gv[bj][n] = *(const f32x4*)(gb + col0 + bj * HALF + n * 16);
#pragma unroll
        for (int ai = 0; ai < 2; ++ai)
#pragma unroll
            for (int m = 0; m < 4; ++m) { const size_t off = (size_t)(row0 + ai * HALF + m * 16) * 2048 + col0;
#pragma unroll
                for (int bj = 0; bj < 2; ++bj)
#pragma unroll
                    for (int n = 0; n < 2; ++n) { const f32x4 bs = *(const f32x4*)(base + off + bj * HALF + n * 16);
                        *(f32x4*)(out + off + bj * HALF + n * 16) = bs + gv[bj][n] * acc[ai][bj][m][n]; } }
    }
};
struct EpiUp {
    static constexpr bool PERM = true, AFTER_DRAIN = false;
    u16* U; u16* SIDE;
    __device__ __forceinline__ void operator()(const f32x4 (&acc)[2][2][4][2], const Unit& u, int wr, int wc, int fr, int fq) const {
        const int row0 = u.pm * BM + wr * 64 + fr, col0 = u.pn * BM + wc * 32 + 8 * fq;
#pragma unroll
        for (int ai = 0; ai < 2; ++ai)
#pragma unroll
            for (int m = 0; m < 4; ++m) { const int r = row0 + ai * HALF + m * 16;
                const bool first = ((m & 1) == 0) && fr == 0, last = ((m & 1) == 1) && fr == 15;
#pragma unroll
                for (int bj = 0; bj < 2; ++bj) { const int c = col0 + bj * HALF;
                    const f32x4 v0 = acc[ai][bj][m][0], v1 = acc[ai][bj][m][1];
                    u32x4 w; w.x = cvtpk(v0[0], v0[1]); w.y = cvtpk(v0[2], v0[3]); w.z = cvtpk(v1[0], v1[1]); w.w = cvtpk(v1[2], v1[3]);
                    *(u32x4*)(U + (size_t)r * FF2 + c) = w;
                    if (first) *(u32x4*)(SIDE + ((size_t)(r >> 5) * 2 + 0) * FF2 + c) = w;
                    if (last)  *(u32x4*)(SIDE + ((size_t)(r >> 5) * 2 + 1) * FF2 + c) = w; } }
    }
};
struct EpiNone {
    static constexpr bool PERM = true, AFTER_DRAIN = false; float* sink;
    __device__ __forceinline__ void operator()(const f32x4 (&acc)[2][2][4][2], const Unit& u, int wr, int wc, int fr, int fq) const {
        f32x4 s = acc[0][0][0][0];
#pragma unroll
        for (int ai = 0; ai < 2; ++ai)
#pragma unroll
            for (int bj = 0; bj < 2; ++bj)
#pragma unroll
                for (int m = 0; m < 4; ++m)
#pragma unroll
                    for (int n = 0; n < 2; ++n) s += acc[ai][bj][m][n];
        if (s[0] + s[1] + s[2] + s[3] == 1.2345e30f) sink[0] = s[0];
    }
};
struct OneUnit {
    Unit u;
    __device__ bool next(int i, Unit& o) const { if (i != 0) return false; o = u; return true; }
    __device__ __forceinline__ void a_ready(const Unit&) const {}
    __device__ __forceinline__ void done(const Unit&) const {}
};
struct EpiConv {
    static constexpr bool PERM = true, AFTER_DRAIN = true;
    u16* Gt; u16* SIDE2; const float* cw; const float* cbv;
    __device__ __forceinline__ void fused(f32x4 (&acc)[2][2][4][2], const Unit& u, int wr, int wc, int fr, int fq, PG8_LAS unsigned char* lds, int wid, int lane) const {
#pragma unroll
        for (int ai = 0; ai < 2; ++ai)
#pragma unroll
            for (int m = 0; m < 4; ++m) { const int row = ai * HALF + wr * 64 + m * 16 + fr;
#pragma unroll
                for (int bj = 0; bj < 2; ++bj) { const int chunk = 16 * bj + 4 * wc + fq;
                    const f32x4 v0 = acc[ai][bj][m][0], v1 = acc[ai][bj][m][1];
                    u32x4 w; w.x = cvtpk(v0[0], v0[1]); w.y = cvtpk(v0[2], v0[3]); w.z = cvtpk(v1[0], v1[1]); w.w = cvtpk(v1[2], v1[3]);
                    *(PG8_LAS u32x4*)(lds + row * 512 + ((chunk ^ (row & 31)) << 4)) = w; } }
        __syncthreads();
        const int t = wid * 64 + lane, c8 = t & 15, r0 = t >> 4, f = u.pn * 128 + c8 * 8;
        float wa[3][8], wb[3][8], ba[8], bb[8];
#pragma unroll
        for (int j = 0; j < 3; ++j)
#pragma unroll
            for (int i = 0; i < 8; ++i) { wa[j][i] = cw[j * FF2 + f + i]; wb[j][i] = cw[j * FF2 + FF + f + i]; }
#pragma unroll
        for (int i = 0; i < 8; ++i) { ba[i] = cbv[f + i]; bb[i] = cbv[FF + f + i]; }
        const u32x4 z = {0u, 0u, 0u, 0u};
#pragma unroll 2
        for (int i8 = 0; i8 < 8; ++i8) { const int r = r0 + 32 * i8;
            u32x4 pa = z, pb = z, na = z, nb = z;
            if (r > 0) { const int q = r - 1; pa = *(const PG8_LAS u32x4*)(lds + q * 512 + ((c8 ^ (q & 31)) << 4)); pb = *(const PG8_LAS u32x4*)(lds + q * 512 + (((16 + c8) ^ (q & 31)) << 4)); }
            if (r < 255) { const int q = r + 1; na = *(const PG8_LAS u32x4*)(lds + q * 512 + ((c8 ^ (q & 31)) << 4)); nb = *(const PG8_LAS u32x4*)(lds + q * 512 + (((16 + c8) ^ (q & 31)) << 4)); }
            const u32x4 ca = *(const PG8_LAS u32x4*)(lds + r * 512 + ((c8 ^ (r & 31)) << 4)), cb = *(const PG8_LAS u32x4*)(lds + r * 512 + (((16 + c8) ^ (r & 31)) << 4));
            u32x4 o;
#pragma unroll
            for (int i = 0; i < 4; ++i) {
                const float a0 = ba[2 * i] + wa[0][2 * i] * bflo(pa[i]) + wa[1][2 * i] * bflo(ca[i]) + wa[2][2 * i] * bflo(na[i]);
                const float a1 = ba[2 * i + 1] + wa[0][2 * i + 1] * bfhi(pa[i]) + wa[1][2 * i + 1] * bfhi(ca[i]) + wa[2][2 * i + 1] * bfhi(na[i]);
                const float b0 = bb[2 * i] + wb[0][2 * i] * bflo(pb[i]) + wb[1][2 * i] * bflo(cb[i]) + wb[2][2 * i] * bflo(nb[i]);
                const float b1 = bb[2 * i + 1] + wb[0][2 * i + 1] * bfhi(pb[i]) + wb[1][2 * i + 1] * bfhi(cb[i]) + wb[2][2 * i + 1] * bfhi(nb[i]);
                o[i] = cvtpk(silu_(a0) * b0, silu_(a1) * b1); }
            *(u32x4*)(Gt + (size_t)(u.pm * BM + r) * FF + f) = o; }
        if (t < 128) { const int rr = t >> 5, ch = t & 31, row = (rr < 2) ? rr : 252 + rr;
            const u32x4 v = *(const PG8_LAS u32x4*)(lds + row * 512 + ((ch ^ (row & 31)) << 4));
            *(u32x4*)(SIDE2 + ((size_t)(u.pm * 44 + u.pn) * 4 + rr) * 256 + ch * 8) = v; }
        __syncthreads();
    }
};
struct EpiResFinal {
    static constexpr bool PERM = false, AFTER_DRAIN = false;
    const float* base; float* out; const float* gate; const float* fw; float* part; unsigned* cnt;
    __device__ __forceinline__ void operator()(const f32x4 (&acc)[2][2][4][2], const Unit& u, int wr, int wc, int fr, int fq) const {
        const int row0 = u.pm * BM + wr * 64 + fr, col0 = u.pn * BM + wc * 32 + 4 * fq;
        const float* gb = gate + (size_t)(u.pm >> 3) * NIN;
        f32x4 gv[2][2];
#pragma unroll
        for (int bj = 0; bj < 2; ++bj)
#pragma unroll
            for (int n = 0; n < 2; ++n) gv[bj][n] = *(const f32x4*)(gb + col0 + bj * HALF + n * 16);
#pragma unroll
        for (int ai = 0; ai < 2; ++ai)
#pragma unroll
            for (int m = 0; m < 4; ++m) { const int r = row0 + ai * HALF + m * 16; const size_t off = (size_t)r * 2048 + col0; float ss = 0.f;
#pragma unroll
                for (int bj = 0; bj < 2; ++bj)
#pragma unroll
                    for (int n = 0; n < 2; ++n) { const f32x4 x2 = *(const f32x4*)(base + off + bj * HALF + n * 16) + gv[bj][n] * acc[ai][bj][m][n];
                        ss += (x2[0] * x2[0] + x2[1] * x2[1]) + (x2[2] * x2[2] + x2[3] * x2[3]); }
                ss += __shfl_xor(ss, 16); ss += __shfl_xor(ss, 32);
                if (fq == 0) __hip_atomic_store(part + (size_t)r * 32 + u.pn * 4 + wc, ss, __ATOMIC_RELAXED, __HIP_MEMORY_SCOPE_AGENT); }
        asm volatile("s_waitcnt vmcnt(0)" ::: "memory");
        unsigned* pc = cnt + 64 * u.pm;
        if ((threadIdx.x & 63) == 0) (void)__hip_atomic_fetch_add(pc, 1u, __ATOMIC_RELAXED, __HIP_MEMORY_SCOPE_AGENT);
        { unsigned sp = 0u;
          while ((unsigned)__builtin_amdgcn_readfirstlane(__hip_atomic_load(pc, __ATOMIC_RELAXED, __HIP_MEMORY_SCOPE_AGENT)) < 64u) { __builtin_amdgcn_s_sleep(2); if (++sp > (1u << 22)) break; } }
        __builtin_amdgcn_fence(__ATOMIC_ACQUIRE, "agent");
        f32x4 wv[2][2];
#pragma unroll
        for (int bj = 0; bj < 2; ++bj)
#pragma unroll
            for (int n = 0; n < 2; ++n) wv[bj][n] = *(const f32x4*)(fw + col0 + bj * HALF + n * 16);
#pragma unroll
        for (int ai = 0; ai < 2; ++ai)
#pragma unroll
            for (int m = 0; m < 4; ++m) { const int r = row0 + ai * HALF + m * 16; const size_t off = (size_t)r * 2048 + col0;
                const f32x4 p0 = *(const f32x4*)(part + (size_t)r * 32 + fq * 8), p1 = *(const f32x4*)(part + (size_t)r * 32 + fq * 8 + 4);
                float tot = ((p0[0] + p0[1]) + (p0[2] + p0[3])) + ((p1[0] + p1[1]) + (p1[2] + p1[3]));
                tot += __shfl_xor(tot, 16); tot += __shfl_xor(tot, 32);
                const float rstd = rsqrtf(tot * (1.f / 2048.f) + EPS);
#pragma unroll
                for (int bj = 0; bj < 2; ++bj)
#pragma unroll
                    for (int n = 0; n < 2; ++n) { const f32x4 x2 = *(const f32x4*)(base + off + bj * HALF + n * 16) + gv[bj][n] * acc[ai][bj][m][n];
                        *(f32x4*)(out + off + bj * HALF + n * 16) = x2 * rstd * wv[bj][n]; } }
    }
};
}

#define KSWZ(row, colB) ((row) * 256 + ((colB) ^ (((row) & 7) << 4)))
#define SBAR() __builtin_amdgcn_sched_barrier(0)
#define MFMA32(a, b, c) __builtin_amdgcn_mfma_f32_32x32x16_bf16((a), (b), (c), 0, 0, 0)
DI int crow(int r, int hi) { return (r & 3) + 8 * (r >> 2) + 4 * hi; }
DI int v_st(int k, int c) { const int kk = (k & ~0xC) | ((k & 4) << 1) | ((k & 8) >> 1); return ((kk >> 3) * 4 + (c >> 5)) * 512 + ((kk & 7) * 32 + (c & 31)) * 2; }
DI int v_rd_base(int lane) { return ((lane & 3) << 3) | (((lane >> 2) & 3) << 6) | (((lane >> 4) & 1) << 5) | (((lane >> 5) & 1) << 8); }
constexpr int v_rd_off(int d0, int ks, int half) { return d0 * 512 + ks * 4096 + half * 2048; }
typedef short v4i16_t __attribute__((ext_vector_type(4)));
typedef LAS const char* lds_cptr;
DI s16x4 vtr(lds_cptr p) { return __builtin_bit_cast(s16x4, __builtin_amdgcn_ds_read_tr16_b64_v4i16((LAS v4i16_t*)p)); }
#define PKF(L, H) (s16x8){L[0], L[1], L[2], L[3], H[0], H[1], H[2], H[3]}
DI void pv_blk(f32x16& od, int vb, s16x8 pa0, s16x8 pa1, s16x8 pa2, s16x8 pa3) {
  const lds_cptr p = (lds_cptr)(uintptr_t)(unsigned)vb;
  const s16x4 l0 = vtr(p + v_rd_off(0, 0, 0)), h0 = vtr(p + v_rd_off(0, 0, 1)), l1 = vtr(p + v_rd_off(0, 1, 0)), h1 = vtr(p + v_rd_off(0, 1, 1));
  const s16x4 l2 = vtr(p + v_rd_off(0, 2, 0)), h2 = vtr(p + v_rd_off(0, 2, 1)), l3 = vtr(p + v_rd_off(0, 3, 0)), h3 = vtr(p + v_rd_off(0, 3, 1));
  od = MFMA32(pa0, PKF(l0, h0), od); od = MFMA32(pa1, PKF(l1, h1), od); od = MFMA32(pa2, PKF(l2, h2), od); od = MFMA32(pa3, PKF(l3, h3), od);
}
DI void tt_blk(f32x16& od, int ab, int vb) {
  const lds_cptr pa = (lds_cptr)(uintptr_t)(unsigned)ab, p = (lds_cptr)(uintptr_t)(unsigned)vb;
#pragma unroll
  for (int ks = 0; ks < 4; ++ks) {
    const s16x4 a0 = vtr(pa + v_rd_off(0, ks, 0)), a1 = vtr(pa + v_rd_off(0, ks, 1)), l0 = vtr(p + v_rd_off(0, ks, 0)), h0 = vtr(p + v_rd_off(0, ks, 1));
    od = MFMA32(PKF(a0, a1), PKF(l0, h0), od); }
}
#define PK4(P, BASE, OUT) do { unsigned a0_ = cvtpk(P[BASE + 0], P[BASE + 1]), a1_ = cvtpk(P[BASE + 2], P[BASE + 3]);   \
    unsigned b0_ = cvtpk(P[BASE + 4], P[BASE + 5]), b1_ = cvtpk(P[BASE + 6], P[BASE + 7]);                              \
    auto r0_ = __builtin_amdgcn_permlane32_swap(a0_, b0_, false, false); auto r1_ = __builtin_amdgcn_permlane32_swap(a1_, b1_, false, false); \
    u32x4v w_ = {r0_[0], r1_[0], r0_[1], r1_[1]}; OUT = __builtin_bit_cast(s16x8, w_); } while (0)

constexpr float ATT_THR = 8.f;
DI void partialSM(f32x16& p0, f32x16& p1, float& m_reg, f32x16& negm, float& alpha) {
  float pmax = fmaxf(p0[0], p0[1]);
#pragma unroll
  for (int r = 2; r < 16; ++r) pmax = fmaxf(pmax, p0[r]);
#pragma unroll
  for (int r = 0; r < 16; ++r) pmax = fmaxf(pmax, p1[r]);
  { auto rr = __builtin_amdgcn_permlane32_swap(__float_as_uint(pmax), __float_as_uint(pmax), false, false);
    pmax = fmaxf(__uint_as_float(rr[0]), __uint_as_float(rr[1])); }
  alpha = 1.f;
  if (__builtin_expect(!__all(pmax <= ATT_THR), 0)) {
    const float dl = fmaxf(pmax, 0.f); m_reg += dl; alpha = __builtin_amdgcn_exp2f(-dl);
#pragma unroll
    for (int r = 0; r < 16; ++r) { p0[r] -= dl; p1[r] -= dl; negm[r] = -m_reg; }
  }
#pragma unroll
  for (int r = 0; r < 16; ++r) p0[r] = __builtin_amdgcn_exp2f(p0[r]);
}
DI void finishSM(f32x16& p0, f32x16& p1, float alpha, float& l_reg, s16x8& pa0, s16x8& pa1, s16x8& pa2, s16x8& pa3) {
#pragma unroll
  for (int r = 0; r < 16; ++r) p1[r] = __builtin_amdgcn_exp2f(p1[r]);
  float ps = 0;
#pragma unroll
  for (int r = 0; r < 16; ++r) ps += p0[r];
#pragma unroll
  for (int r = 0; r < 16; ++r) ps += p1[r];
  { auto rr = __builtin_amdgcn_permlane32_swap(__float_as_uint(ps), __float_as_uint(ps), false, false);
    ps = __uint_as_float(rr[0]) + __uint_as_float(rr[1]); }
  l_reg = l_reg * alpha + ps;
  PK4(p0, 0, pa0); PK4(p0, 8, pa1); PK4(p1, 0, pa2); PK4(p1, 8, pa3);
}
DI void qkt64(f32x16& p0, f32x16& p1, const char* Ks, const s16x8* qr, const f32x16& negm, int comp, int r32, int hi) {
#pragma unroll
  for (int d0 = 0; d0 < 4; ++d0) { const int cb = (comp * 64 + d0 * 16 + hi * 8) * 2;
    const s16x8 b0 = *(const s16x8*)(Ks + KSWZ(r32, cb));
    const s16x8 b1 = *(const s16x8*)(Ks + KSWZ(32 + r32, cb));
    if (d0 == 0) { p0 = MFMA32(b0, qr[0], negm); p1 = MFMA32(b1, qr[0], negm); }
    else { p0 = MFMA32(b0, qr[d0], p0); p1 = MFMA32(b1, qr[d0], p1); } }
}
constexpr int SHM_V = 16384, SHM_K = 16384, ATT_KOFF = 3 * SHM_V, ATT_WS = 3 * SHM_V + 2 * SHM_K  , ATT_X = 0  , ATT_CTR = 135168  ;
DI void pv_all(f32x16* o, int vb, s16x8 pa0, s16x8 pa1, s16x8 pa2, s16x8 pa3) {
  const lds_cptr p = (lds_cptr)(uintptr_t)(unsigned)vb;
  const s16x8 pa[4] = {pa0, pa1, pa2, pa3};
#pragma unroll
  for (int ks = 0; ks < 4; ++ks)
#pragma unroll
    for (int d0 = 0; d0 < 4; ++d0) { const s16x4 l = vtr(p + v_rd_off(d0, ks, 0)), h = vtr(p + v_rd_off(d0, ks, 1)); o[d0] = MFMA32(pa[ks], PKF(l, h), o[d0]); }
}
template <int AV_> DI void attn_unit(const u16* __restrict__ Qb, u16* __restrict__ Ob, const u16* __restrict__ Kh, const u16* __restrict__ Vh, float lam, const float* __restrict__ subw, char* lds) {
  constexpr int LDK = 1024;
  int tid_ = threadIdx.x; asm volatile("" : "+v"(tid_)); const int tid = tid_, wid = __builtin_amdgcn_readfirstlane(tid >> 6), lane = tid & 63, r32 = lane & 31, hi = lane >> 5;
  const int rb = wid >> 1, comp = wid & 1;
  char* V_lds = lds; char* K_lds = lds + ATT_KOFF;
  float* ws = (float*)(lds + ATT_WS) + wid * 64; float* li_l = ws; float* al_l = ws + 32;
  float m_reg = 0.f, l_reg = 0; f32x16 o[4] = {}; s16x8 qr[4]; f32x16 negm = {};
  const u16* Qw = Qb + (size_t)(rb * 32 + r32) * LDK + comp * 64 + hi * 8;
#pragma unroll
  for (int d0 = 0; d0 < 4; ++d0) qr[d0] = *(const s16x8*)(Qw + d0 * 16);
  const int vb0 = (int)(uintptr_t)V_lds + v_rd_base(lane);
  const char* ksrc[2]; const char* vsrc[2];
#pragma unroll
  for (int i = 0; i < 2; ++i) { const int q = wid + 8 * i;
    { const int row = 4 * q + (lane >> 4), colB = ((lane & 15) * 16) ^ ((row & 7) << 4); ksrc[i] = (const char*)(Kh + (size_t)row * LDK) + colB; }
    { const int st = 2 * q + (lane >> 5), kkx = (st >> 2) * 8 + ((lane & 31) >> 2), c = (st & 3) * 32 + (lane & 3) * 8;
      const int key = (kkx & ~0xC) | ((kkx & 4) << 1) | ((kkx & 8) >> 1); vsrc[i] = (const char*)(Vh + (size_t)key * LDK + c); } }
  const LAS unsigned char* ldsb = (const LAS unsigned char*)lds;
#define SDMA(k0, kb_, vb_) do { const size_t go_ = (size_t)(k0) * LDK * 2; _Pragma("unroll") for (int i_ = 0; i_ < 2; ++i_) { \
    __builtin_amdgcn_global_load_lds((const unsigned*)(ksrc[i_] + go_), (LAS unsigned*)(ldsb + ATT_KOFF + (kb_) * SHM_K + (wid + 8 * i_) * 1024), 16, 0, 0); \
    __builtin_amdgcn_global_load_lds((const unsigned*)(vsrc[i_] + go_), (LAS unsigned*)(ldsb + (vb_) * SHM_V + (wid + 8 * i_) * 1024), 16, 0, 0); } } while (0)
#define SLAND() asm volatile("s_waitcnt vmcnt(0)" ::: "memory")
#define RESCALE(al_) do { if (__any((al_) < 1.f)) { if (hi == 0) al_l[r32] = (al_); LDS_WAIT(); \
    _Pragma("unroll") for (int d = 0; d < 4; ++d) _Pragma("unroll") for (int r = 0; r < 16; ++r) o[d][r] *= al_l[crow(r, hi)]; } } while (0)
  constexpr int NT = TKV / 64;
  f32x16 pA0, pA1, pB0, pB1; float alA, alB; s16x8 pa0, pa1, pa2, pa3;
  SDMA(0, 0, 0); SLAND(); __syncthreads();
  SDMA(64, 1, 1);
  qkt64(pA0, pA1, K_lds, qr, negm, comp, r32, hi); partialSM(pA0, pA1, m_reg, negm, alA);
  SLAND(); __syncthreads();
  int vprev = 0, vnext = 2;
#define VROT() do { vprev = (vprev == 2) ? 0 : vprev + 1; vnext = (vnext == 2) ? 0 : vnext + 1; } while (0)
  for (int j = 1; j + 1 < NT; j += 2) {
    SDMA((j + 1) * 64, 0, vnext);
    qkt64(pB0, pB1, K_lds + SHM_K, qr, negm, comp, r32, hi);
    finishSM(pA0, pA1, alA, l_reg, pa0, pa1, pa2, pa3);
    pv_all(o, vb0 + vprev * SHM_V, pa0, pa1, pa2, pa3);
    partialSM(pB0, pB1, m_reg, negm, alB);
    RESCALE(alB);
    SLAND(); VROT(); __syncthreads();
    if (j + 2 < NT) SDMA((j + 2) * 64, 1, vnext);
    qkt64(pA0, pA1, K_lds, qr, negm, comp, r32, hi);
    finishSM(pB0, pB1, alB, l_reg, pa0, pa1, pa2, pa3);
    pv_all(o, vb0 + vprev * SHM_V, pa0, pa1, pa2, pa3);
    partialSM(pA0, pA1, m_reg, negm, alA);
    RESCALE(alA);
    SLAND(); VROT(); __syncthreads();
  }
  qkt64(pB0, pB1, K_lds + SHM_K, qr, negm, comp, r32, hi);
  finishSM(pA0, pA1, alA, l_reg, pa0, pa1, pa2, pa3);
  pv_all(o, vb0 + vprev * SHM_V, pa0, pa1, pa2, pa3);
  partialSM(pB0, pB1, m_reg, negm, alB);
  RESCALE(alB);
  VROT();
  finishSM(pB0, pB1, alB, l_reg, pa0, pa1, pa2, pa3);
  pv_all(o, vb0 + vprev * SHM_V, pa0, pa1, pa2, pa3);
  __syncthreads();
#undef VROT
  if (hi == 0) li_l[r32] = l_reg; LDS_WAIT();
  float rli[16];
#pragma unroll
  for (int r = 0; r < 16; ++r) rli[r] = __builtin_amdgcn_rcpf(li_l[crow(r, hi)]);
  float* X = (float*)(lds + ATT_X) + rb * 4096;
  if (comp == 1) {
#pragma unroll
    for (int r = 0; r < 16; ++r)
#pragma unroll
      for (int d0 = 0; d0 < 4; ++d0) X[crow(r, hi) * 128 + d0 * 32 + r32] = lam * o[d0][r] * rli[r];
  }
  __syncthreads();
  if (comp == 0) {
    float sw[4];
#pragma unroll
    for (int d0 = 0; d0 < 4; ++d0) sw[d0] = subw[d0 * 32 + r32] * 0.8f;
    u16* Ow = Ob + (size_t)(rb * 32) * LDK;
#pragma unroll
    for (int r = 0; r < 16; ++r) { const int orow = crow(r, hi); float ss = 0.f; float v[4];
#pragma unroll
      for (int d0 = 0; d0 < 4; ++d0) { v[d0] = o[d0][r] * rli[r] - X[orow * 128 + d0 * 32 + r32]; ss += v[d0] * v[d0]; }
#pragma unroll
      for (int of = 1; of < 32; of <<= 1) ss += __shfl_xor(ss, of);
      const float rs = rsqrtf(ss * (1.f / 128.f) + EPS);
#pragma unroll
      for (int d0 = 0; d0 < 4; ++d0) Ow[(size_t)orow * LDK + d0 * 32 + r32] = f2bf(v[d0] * rs * sw[d0]); }
  }
  __syncthreads();
#undef SDMA
#undef SLAND
#undef RESCALE
}

constexpr int SC_QP = 0, SC_KP = 16384, SC_QT = 32768, SC_KH = 49152, SC_VV = 65536, SC_SS = 81920, SC_TOT = 114688, SC_BEND = 118784;
template <int VAR> DI void scan_item(int b, int h, int dir, const u16* __restrict__ KKb, const u16* __restrict__ RI, const u16* __restrict__ RQ, u16* __restrict__ OUT, char* lds) {
  int tid_ = threadIdx.x; asm volatile("" : "+v"(tid_)); const int tid = tid_, wid = __builtin_amdgcn_readfirstlane(tid >> 6), lane = tid & 63, r32 = lane & 31, hi = lane >> 5;
  const int k0 = 2 * lane, seg = wid;
  const int tb = wid >> 2, vb = wid & 3, kb0 = 2 * (wid >> 2);
  const int colh = h * 128;
  float* TOT = (float*)(lds + SC_TOT); float* BEND = (float*)(lds + SC_BEND);
  const int lbase = (int)(uintptr_t)lds;
  const int rdb = v_rd_base(lane);
  f32x16 s0 = {}, s1 = {};
  { u32x4v z = {0u, 0u, 0u, 0u}; *(u32x4v*)(lds + SC_SS + tid * 64) = z; *(u32x4v*)(lds + SC_SS + tid * 64 + 16) = z; *(u32x4v*)(lds + SC_SS + tid * 64 + 32) = z; *(u32x4v*)(lds + SC_SS + tid * 64 + 48) = z; }
  const int sr = tid >> 4, sc = (tid & 15) * 8;
  unsigned gr[8], qv[8]; s16x8 vr0, vr1;
#define SC_LOAD(step_) do { const int st_ = (step_); const bool cx_ = st_ < 4; const int c_ = cx_ ? st_ : st_ - 4; \
    const int ch_ = dir ? (cx_ ? 3 - c_ : 31 - c_) : c_; const unsigned kvb_ = (unsigned)(b * TKV + (cx_ ? SEQ : 0) + ch_ * 64); const unsigned ltb_ = (unsigned)(b * SEQ + ch_ * 64); \
    _Pragma("unroll") for (int j = 0; j < 8; ++j) { const int i_ = 8 * seg + j, tk_ = dir ? 63 - i_ : i_; gr[j] = *(const unsigned*)(KKb + (unsigned)((kvb_ + tk_) * 1024u + colh + k0)); \
      if (!cx_) qv[j] = *(const unsigned*)(RQ + (unsigned)((ltb_ + tk_) * 1024u + colh + k0)); } \
    { const int t0_ = dir ? 63 - sr : sr, t1_ = dir ? 31 - sr : 32 + sr; vr0 = *(const s16x8*)(RI + (unsigned)((kvb_ + t0_) * 1024u + colh + sc)); vr1 = *(const s16x8*)(RI + (unsigned)((kvb_ + t1_) * 1024u + colh + sc)); } } while (0)
  SC_LOAD(0);
  for (int step = 0; step < 36; ++step) {
    const bool isctx = step < 4; const int c = isctx ? step : step - 4;
    const int chunk = dir ? (isctx ? 3 - c : 31 - c) : c;
    const unsigned latbase = (unsigned)(b * SEQ + chunk * 64);
    f32x2 kk[8], q[8], P[8];
#pragma unroll
    for (int j = 0; j < 8; ++j) { kk[j] = (f32x2){1.f - fexp(h2f((u16)(gr[j] & 0xffffu))), 1.f - fexp(h2f((u16)(gr[j] >> 16)))}; q[j] = isctx ? (f32x2){0.f, 0.f} : (f32x2){bflo(qv[j]), bfhi(qv[j])}; }
    { f32x2 a = {1.f, 1.f};
#pragma unroll
      for (int j = 0; j < 8; ++j) { a = a * (1.f - kk[j]); P[j] = a; }
      *(f32x2*)(TOT + seg * 128 + k0) = a; }
    const s16x8 cv0 = vr0, cv1 = vr1;
    __syncthreads();
    if (step + 1 < 36) SC_LOAD(step + 1);
    if (VAR != 2 && VAR != 3) { f32x2 pre = {1.f, 1.f}, suf = {1.f, 1.f}, mid = {1.f, 1.f};
#pragma unroll
      for (int s_ = 0; s_ < 8; ++s_) { const f32x2 t = *(const f32x2*)(TOT + s_ * 128 + k0);
        if (s_ < seg) pre = pre * t;
        if (s_ > seg) suf = suf * t;
        if (seg <= 3 ? (s_ > seg && s_ <= 3) : (s_ >= 4 && s_ < seg)) mid = mid * t; }
      if (seg == 7) *(f32x2*)(BEND + k0) = pre * P[7];
      f32x2 sl = {1.f, 1.f};
#pragma unroll
      for (int j = 7; j >= 0; --j) { const int i = 8 * seg + j;
        const f32x2 khat = kk[j] * (sl * suf);
        *(unsigned*)(lds + SC_KH + v_st(i, k0)) = cvtpk(khat.x, khat.y);
        if (!isctx) {
          const f32x2 qt = q[j] * (pre * P[j]);
          f32x2 e1, e2;
          if (seg <= 3) { e2 = sl * mid; e1.x = __builtin_amdgcn_rcpf(fmaxf(e2.x, 1e-30f)); e1.y = __builtin_amdgcn_rcpf(fmaxf(e2.y, 1e-30f)); }
          else { e1 = mid * P[j]; e2.x = __builtin_amdgcn_rcpf(fmaxf(e1.x, 1e-30f)); e2.y = __builtin_amdgcn_rcpf(fmaxf(e1.y, 1e-30f)); }
          const f32x2 qp = q[j] * e1, kp = kk[j] * e2;
          const int o2 = KSWZ(i, k0 * 2);
          *(unsigned*)(lds + SC_QT + o2) = cvtpk(qt.x, qt.y); *(unsigned*)(lds + SC_QP + o2) = cvtpk(qp.x, qp.y); *(unsigned*)(lds + SC_KP + o2) = cvtpk(kp.x, kp.y); }
        sl = sl * (1.f - kk[j]); }
      *(s16x8*)(lds + SC_VV + v_st(sr, sc)) = cv0; *(s16x8*)(lds + SC_VV + v_st(32 + sr, sc)) = cv1; }
    __syncthreads();
    if (VAR != 1 && VAR != 3) {
    if (!isctx) {
      f32x16 p0 = {}, p1 = {};
      const int trow = tb * 32 + r32;
#pragma unroll
      for (int ks = 0; ks < 8; ++ks) { const int cb = (ks * 16 + hi * 8) * 2;
        const s16x8 qf = *(const s16x8*)(lds + SC_QP + KSWZ(trow, cb));
        const s16x8 kf0 = *(const s16x8*)(lds + SC_KP + KSWZ(r32, cb));
        p0 = MFMA32(kf0, qf, p0);
        if (tb == 1) { const s16x8 kf1 = *(const s16x8*)(lds + SC_KP + KSWZ(32 + r32, cb)); p1 = MFMA32(kf1, qf, p1); } }
      { int dd = r32 - 4 * hi; asm volatile("" : "+v"(dd));
        if (tb == 0) {
#pragma unroll
          for (int r = 0; r < 16; ++r) { if ((r & 3) + 8 * (r >> 2) > dd) p0[r] = 0.f; p1[r] = 0.f; }
        } else {
#pragma unroll
          for (int r = 0; r < 16; ++r) { if ((r & 3) + 8 * (r >> 2) > dd) p1[r] = 0.f; }
        } }
      s16x8 pa0, pa1, pa2, pa3;
      PK4(p0, 0, pa0); PK4(p0, 8, pa1); PK4(p1, 0, pa2); PK4(p1, 8, pa3);
      f32x16 o = {};
      pv_blk(o, lbase + SC_VV + rdb + vb * 512, pa0, pa1, pa2, pa3);
#pragma unroll
      for (int ks = 0; ks < 8; ++ks) { const int cb = (ks * 16 + hi * 8) * 2;
        const s16x8 qa = *(const s16x8*)(lds + SC_QT + KSWZ(trow, cb));
        const s16x8 sb = *(const s16x8*)(lds + SC_SS + KSWZ(vb * 32 + r32, cb));
        o = MFMA32(qa, sb, o); }
#pragma unroll
      for (int r = 0; r < 16; ++r) { const int t = tb * 32 + crow(r, hi), tk = dir ? 63 - t : t;
        OUT[(unsigned)((VAR ? ((latbase + tk) & 1023u) : (latbase + tk)) * 1024u + colh + vb * 32 + r32)] = f2bf(o[r]); }
    }
#pragma unroll
    for (int g = 0; g < 4; ++g) { const f32x4v d0 = *(const f32x4v*)(BEND + kb0 * 32 + 8 * g + 4 * hi), d1 = *(const f32x4v*)(BEND + kb0 * 32 + 32 + 8 * g + 4 * hi);
#pragma unroll
      for (int i = 0; i < 4; ++i) { s0[4 * g + i] *= d0[i]; s1[4 * g + i] *= d1[i]; } }
    tt_blk(s0, lbase + SC_KH + rdb + kb0 * 512, lbase + SC_VV + rdb + vb * 512);
    tt_blk(s1, lbase + SC_KH + rdb + (kb0 + 1) * 512, lbase + SC_VV + rdb + vb * 512);
    }
    __syncthreads();
#pragma unroll
    for (int g = 0; g < 4; ++g) { const int vrow = vb * 32 + r32, kc0 = (kb0 * 32 + 8 * g + 4 * hi) * 2, kc1 = kc0 + 64;
      u32x2v w0 = {cvtpk(s0[4 * g], s0[4 * g + 1]), cvtpk(s0[4 * g + 2], s0[4 * g + 3])}, w1 = {cvtpk(s1[4 * g], s1[4 * g + 1]), cvtpk(s1[4 * g + 2], s1[4 * g + 3])};
      *(u32x2v*)(lds + SC_SS + KSWZ(vrow, kc0)) = w0; *(u32x2v*)(lds + SC_SS + KSWZ(vrow, kc1)) = w1; }
  }
  __syncthreads();
#undef SC_LOAD
}
#define XB_TMO      128
#define XB_XCNT(j)  (256  + 64 * (j))
#define XB_XSUB(j)  (1280 + 64 * (j))
#define XB_XGEN(j)  (2304 + 64 * (j))
#define XB_TOP      3328
#define XB_TOPGEN   3392
#define XCD_BAR_WORDS 3456
#define XB_SPIN_CAP (1u << 18)

__device__ __forceinline__ unsigned xb_ld(unsigned* p)              { return __hip_atomic_load(p, __ATOMIC_RELAXED, __HIP_MEMORY_SCOPE_AGENT); }
__device__ __forceinline__ unsigned xb_add(unsigned* p, unsigned v) { return __hip_atomic_fetch_add(p, v, __ATOMIC_RELAXED, __HIP_MEMORY_SCOPE_AGENT); }
__device__ __forceinline__ unsigned xb_xcc_id() { return (unsigned)__builtin_amdgcn_s_getreg((3 << 11) | 20) & 0xFu; }
#define XB_SPIN(cond, bar) do { unsigned _sp = 0; while (cond) { __builtin_amdgcn_s_sleep(1); \
    if ((++_sp & 255u) == 0u) { if (xb_ld(&(bar)[XB_TMO])) break; if (_sp > XB_SPIN_CAP) { atomicAdd(&(bar)[XB_TMO], 1u); break; } } } } while (0)

struct XcdBarrier {
    unsigned* bar; unsigned x;
    volatile LAS unsigned* st;
};

__device__ __forceinline__ XcdBarrier xcd_barrier_post(unsigned* bar, volatile LAS unsigned* st) {
    XcdBarrier b; b.bar = bar; b.x = xb_xcc_id(); b.st = st;
    if (threadIdx.x == 0) (void)xb_add(&bar[XB_XCNT(b.x)], 1u);
    return b;
}
__device__ __forceinline__ void xcd_barrier_complete(unsigned* bar, unsigned x, unsigned& nloc, unsigned& nx) {
    const unsigned G = gridDim.x * gridDim.y * gridDim.z;
    unsigned sum, cnt, mine, sp = 0u;
    for (;;) {
        sum = 0u; cnt = 0u; mine = 0u;
#pragma unroll
        for (unsigned j = 0; j < 16; ++j) { const unsigned c = xb_ld(&bar[XB_XCNT(j)]); sum += c; cnt += (c > 0u) ? 1u : 0u; mine = (j == x) ? c : mine; }
        if (sum == G) break;
        __builtin_amdgcn_s_sleep(1);
        if ((++sp & 255u) == 0u) { if (xb_ld(&bar[XB_TMO])) break; if (sp > XB_SPIN_CAP) { atomicAdd(&bar[XB_TMO], 1u); break; } }
    }
    nloc = mine > 0u ? mine : 1u; nx = cnt > 0u ? cnt : 1u;
}

__device__ __forceinline__ void xcd_barrier(const XcdBarrier& b) {
    asm volatile("s_waitcnt vmcnt(0)" ::: "memory");
    __syncthreads();
    if (threadIdx.x == 0) {
        unsigned* bar = b.bar;
        __builtin_amdgcn_s_waitcnt(0);
        unsigned nloc = b.st[0], nx = b.st[1];
        if (nloc == 0u) { xcd_barrier_complete(bar, b.x, nloc, nx); b.st[0] = nloc; b.st[1] = nx; }
        const unsigned old = xb_add(&bar[XB_XSUB(b.x)], 1u);
        const unsigned gen = old / nloc;
        if (old + 1u == (gen + 1u) * nloc) {
            __builtin_amdgcn_fence(__ATOMIC_RELEASE, "agent");
            asm volatile("s_waitcnt vmcnt(0)" ::: "memory");
            const unsigned og = xb_add(&bar[XB_TOP], 1u);
            const unsigned tg = og / nx;
            if (og + 1u == (tg + 1u) * nx) xb_add(&bar[XB_TOPGEN], 1u);
            else XB_SPIN(xb_ld(&bar[XB_TOPGEN]) == tg, bar);
            __builtin_amdgcn_fence(__ATOMIC_ACQUIRE, "agent");
            xb_add(&bar[XB_XGEN(b.x)], 1u);
            asm volatile("s_waitcnt vmcnt(0)" ::: "memory");
        } else {
            XB_SPIN(xb_ld(&bar[XB_XGEN(b.x)]) == gen, bar);
            __builtin_amdgcn_fence(__ATOMIC_ACQUIRE, "agent");
            asm volatile("s_waitcnt vmcnt(0)" ::: "memory");
        }
    }
    __syncthreads();
}

#ifndef DUP_MASK
#define DUP_MASK 0
#endif
#ifndef PHASES
#define PHASES 0xfff
#endif
struct Params {
  const float *x, *c, *ctx, *c_ctx, *w_mod, *b_mod, *norm1_w, *w_in, *lam_q1, *lam_k1, *lam_q2, *lam_k2, *subln_w, *rec_lb, *rec_gnorm_w,
              *w_branch_attn, *w_branch_rec, *w_out, *norm2_w, *w_up, *conv_w, *conv_b, *w_down, *final_norm_w;
  float* out; unsigned char* ws;
};
DI int cperm(int p) { return 16 * ((p >> 2) & 1) + 4 * (p >> 3) + (p & 3); }
DI void transpose_item(const float* __restrict__ W, int K, int N, u16* __restrict__ WT, float* scr, int item, int lane, bool perm, bool pair_up = false) {
  const int nblk = N / 32, kb = item / nblk, nb = item % nblk, k0 = 64 * kb, n0 = 32 * nb;
  const int ns0 = pair_up ? (((n0 & 255) < 128) ? 128 * (n0 >> 8) + (n0 & 255) : FF + 128 * (n0 >> 8) + (n0 & 255) - 128) : n0;
  float tv[32];
#pragma unroll
  for (int i = 0; i < 32; ++i) { const int kk = 2 * i + (lane >> 5); tv[i] = W[(size_t)(k0 + kk) * N + ns0 + (lane & 31)]; }
#pragma unroll
  for (int i = 0; i < 32; ++i) { const int kk = 2 * i + (lane >> 5); scr[kk * 33 + (lane & 31)] = tv[i]; }
  LDS_WAIT(); asm volatile("" ::: "memory");
  const int c = lane & 7;
#pragma unroll
  for (int j = 0; j < 4; ++j) { const int n = (lane >> 3) + 8 * j; const float* s = scr + (8 * c) * 33 + (perm ? cperm(n) : n);
    u32x4v o; o.x = cvtpk(s[0 * 33], s[1 * 33]); o.y = cvtpk(s[2 * 33], s[3 * 33]); o.z = cvtpk(s[4 * 33], s[5 * 33]); o.w = cvtpk(s[6 * 33], s[7 * 33]);
    *(u32x4v*)(WT + (size_t)(n0 + n) * K + k0 + 8 * c) = o; }
  LDS_WAIT(); asm volatile("" ::: "memory");
}
DI void mod_item(const Params& p, float* mod, int item, int lane) {
  const int cb = item % 48, kch = item / 48, c0 = cb * 256 + lane * 4, k0 = kch * 64;
  float sv[9];
#pragma unroll
  for (int r = 0; r < 8; ++r) sv[r] = silu_(p.c[r * DM + k0 + lane]);
  sv[8] = silu_(p.c_ctx[k0 + lane]);
  f32x4v acc[9];
#pragma unroll
  for (int r = 0; r < 9; ++r) acc[r] = (f32x4v){0.f, 0.f, 0.f, 0.f};
  if (kch == 0) { const f32x4v bv = *(const f32x4v*)(p.b_mod + c0);
#pragma unroll
    for (int r = 0; r < 9; ++r) acc[r] = bv; }
#pragma unroll 4
  for (int kk = 0; kk < 64; ++kk) { const f32x4v w = *(const f32x4v*)(p.w_mod + (size_t)(k0 + kk) * NIN + c0);
#pragma unroll
    for (int r = 0; r < 9; ++r) { const float s = __shfl(sv[r], kk); acc[r] += w * s; } }
#pragma unroll
  for (int r = 0; r < 9; ++r)
#pragma unroll
    for (int j = 0; j < 4; ++j) unsafeAtomicAdd(mod + (size_t)r * NIN + c0 + j, acc[r][j]);
}
DI void sincos_small(float a, float& sn, float& cs) {
  const double x = (double)a; const double kq = __builtin_rint(x * 0.63661977236758134308);
  const double r = (x - kq * 1.5707963267948966192) ; const double r2 = r * r;
  double s = r * (1.0 + r2 * (-1.0 / 6 + r2 * (1.0 / 120 + r2 * (-1.0 / 5040 + r2 * (1.0 / 362880 + r2 * (-1.0 / 39916800 + r2 * (1.0 / 6227020800.0)))))));
  double c = 1.0 + r2 * (-0.5 + r2 * (1.0 / 24 + r2 * (-1.0 / 720 + r2 * (1.0 / 40320 + r2 * (-1.0 / 3628800 + r2 * (1.0 / 479001600 + r2 * (-1.0 / 87178291200.0)))))));
  const int q = ((int)kq) & 3;
  const double ss = (q == 0) ? s : (q == 1) ? c : (q == 2) ? -s : -c;
  const double cc = (q == 0) ? c : (q == 1) ? -s : (q == 2) ? -c : s;
  sn = (float)ss; cs = (float)cc;
}
DI void norm_mod_row(const float* __restrict__ xrow, const float* __restrict__ nw, const float* __restrict__ sc, const float* __restrict__ sh, u16* __restrict__ orow, int lane) {
  const f32x4v* xr = (const f32x4v*)xrow + lane; f32x4v v[8]; float s = 0.f;
#pragma unroll
  for (int j = 0; j < 8; ++j) { v[j] = xr[64 * j]; s += (v[j].x * v[j].x + v[j].y * v[j].y) + (v[j].z * v[j].z + v[j].w * v[j].w); }
  const float rstd = rsqrtf(wave_sum(s) * (1.f / DM) + EPS);
#pragma unroll
  for (int j = 0; j < 8; ++j) { const int c = 4 * (lane + 64 * j);
    const f32x4v w = *(const f32x4v*)(nw + c), a = *(const f32x4v*)(sc + c), d = *(const f32x4v*)(sh + c);
    const f32x4v y = v[j] * rstd * w * (1.f + a) + d;
    u32x2v o; o.x = cvtpk(y.x, y.y); o.y = cvtpk(y.z, y.w); *(u32x2v*)(orow + c) = o; }
}

DI void rec_readout_row(const u16* __restrict__ OF, const u16* __restrict__ OB, u16* RG, const float* __restrict__ gnw, int m, int lane) {
    const size_t off = (size_t)m * 1024 + lane * 16;
    const u32x4v a0 = *(const u32x4v*)(OF + off), a1 = *(const u32x4v*)(OF + off + 8), b0 = *(const u32x4v*)(OB + off), b1 = *(const u32x4v*)(OB + off + 8);
    const u32x4v g0 = *(const u32x4v*)(RG + off), g1 = *(const u32x4v*)(RG + off + 8);
    float v[16]; float s = 0.f;
#pragma unroll
    for (int i = 0; i < 4; ++i) { v[2 * i] = bflo(a0[i]) + bflo(b0[i]); v[2 * i + 1] = bfhi(a0[i]) + bfhi(b0[i]); v[8 + 2 * i] = bflo(a1[i]) + bflo(b1[i]); v[8 + 2 * i + 1] = bfhi(a1[i]) + bfhi(b1[i]); }
#pragma unroll
    for (int i = 0; i < 16; ++i) s += v[i] * v[i];
    const float rstd = rsqrtf(wave_sum(s) * (1.f / 1024.f) + EPS);
    const float* gw_ = gnw + lane * 16;
    u32x4v o0, o1;
#pragma unroll
    for (int i = 0; i < 4; ++i) {
      o0[i] = cvtpk(v[2 * i] * rstd * gw_[2 * i] * bflo(g0[i]), v[2 * i + 1] * rstd * gw_[2 * i + 1] * bfhi(g0[i]));
      o1[i] = cvtpk(v[8 + 2 * i] * rstd * gw_[8 + 2 * i] * bflo(g1[i]), v[8 + 2 * i + 1] * rstd * gw_[8 + 2 * i + 1] * bfhi(g1[i])); }
    *(u32x4v*)(RG + off) = o0; *(u32x4v*)(RG + off + 8) = o1;
}
typedef const __attribute__((address_space(4))) Params* KargP;
#if defined(__HIP_DEVICE_COMPILE__)
#define LOAD_PARAMS() KargP kp_ = (KargP)__builtin_amdgcn_kernarg_segment_ptr(); asm volatile("" : "+s"(kp_)); const Params p = *kp_;
#else
#define LOAD_PARAMS() const Params p = p_unused;
#endif
#define PHASE_BEGIN() \
  LOAD_PARAMS() \
  int tid_ = threadIdx.x; asm volatile("" : "+v"(tid_)); const int tid = tid_, lane = tid & 63, wave = __builtin_amdgcn_readfirstlane(tid >> 6); \
  const int G = gridDim.x, bx = blockIdx.x, gw = bx * 8 + wave, NGW = G * 8; (void)gw; (void)NGW; (void)lane; \
  unsigned char* ws = p.ws; float* ctl = (float*)(ws + WS_CTL); float* mod = ctl + C_MOD; (void)mod; \
  char* lds = (char*)lds_raw; (void)lds; pg8::LdsPtr glds = (pg8::LdsPtr)lds_raw; (void)glds;
#define WSP(name, off) u16* name = (u16*)(ws + (off))
__global__ void __launch_bounds__(512, 2) fwd_megakernel(Params p_unused) {
  extern __shared__ __attribute__((aligned(16))) unsigned char lds_raw[];
  cg::grid_group grid = cg::this_grid();
  { volatile LAS unsigned* st_ = (volatile LAS unsigned*)((LAS unsigned char*)lds_raw + XB_LDS_OFF);
    if (threadIdx.x < 2) st_[threadIdx.x] = 0u;
    __syncthreads();
    LOAD_PARAMS()
    (void)xcd_barrier_post((unsigned*)(p.ws + WS_CTL) + C_BAR, st_); }
#define FAST_SYNC() do { LOAD_PARAMS() XcdBarrier xb_; xb_.bar = (unsigned*)(p.ws + WS_CTL) + C_BAR; xb_.x = xb_xcc_id(); \
    xb_.st = (volatile LAS unsigned*)((LAS unsigned char*)lds_raw + XB_LDS_OFF); xcd_barrier(xb_); } while (0)
  _Pragma("unroll") for (int rep = 0; rep <= ((DUP_MASK >> 0) & 1); ++rep) {
  if (PHASES & (1 << 0)) {
  PHASE_BEGIN() WSP(WUP, WS_WUP); WSP(WDN, WS_WDN); WSP(WIN, WS_WIN); WSP(WBA, WS_WBA); WSP(WBR, WS_WBR); WSP(WOUT, WS_WOUT);
  {
    float* scr = (float*)(lds + wave * 16384);
    constexpr int I_IN = 32 * 384, I_UP = 32 * 352;
    constexpr int NITEMS = I_IN + I_UP;
    if (rep == 0 && gw < 1536) mod_item(p, mod, gw, lane);
    for (int it = gw; it < NITEMS; it += NGW) {
      int r = it;
      if (r < I_IN) { const int nb = r % 384; transpose_item(p.w_in, DM, NIN, WIN, scr, r, lane, (nb < 32) || (nb >= 160 && nb < 192)); continue; } r -= I_IN;
      transpose_item(p.w_up, DM, FF2, WUP, scr, r, lane, false, true);
    }
    if (bx == G - 1) {
      if (wave == 0) { const float a = wave_sum(p.lam_q1[lane] * p.lam_k1[lane]), bq = wave_sum(p.lam_q2[lane] * p.lam_k2[lane]);
        if (lane == 0) ctl[C_LAM] = __expf(a) - __expf(bq) + 0.2f; }
      for (int k = tid; k < 1024; k += 512) { ctl[C_LBF + k] = sigm(p.rec_lb[k] - p.rec_lb[1024 + k]); ctl[C_LBB + k] = sigm(p.rec_lb[2048 + k] - p.rec_lb[3072 + k]); }
    }
    if (bx == G - 2) {
      for (int e = tid; e < 1024; e += 512) { const int pos = e >> 4, j = e & 15; const float iv = __builtin_amdgcn_exp2f(-(float)j * 0.83048202372184058696f);
        float sn, cs; sincos_small((float)pos * iv, sn, cs); ctl[C_COS + e] = cs; ctl[C_SIN + e] = sn; }
    }
  }
  }
  FAST_SYNC();
  if (gridDim.x == 0x7fffffffu) grid.sync();
  }
  _Pragma("unroll") for (int rep = 0; rep <= ((DUP_MASK >> 1) & 1); ++rep) {
  if (PHASES & (1 << 1)) {
  PHASE_BEGIN() WSP(H, WS_H);
  for (int m = gw; m < MALL; m += NGW) {
    if (m < MTOK) { const float* mr = mod + (size_t)(m >> 11) * NIN; norm_mod_row(p.x + (size_t)m * DM, p.norm1_w, mr + 2048, mr, H + (size_t)m * DM, lane); }
    else { const float* mr = mod + (size_t)8 * NIN; norm_mod_row(p.ctx + (size_t)(m - MTOK) * DM, p.norm1_w, mr + 2048, mr, H + (size_t)m * DM, lane); }
  }
  }
  FAST_SYNC();
  }
  _Pragma("unroll") for (int rep = 0; rep <= ((DUP_MASK >> 2) & 1); ++rep) {
  if (PHASES & (1 << 2)) {
  PHASE_BEGIN() WSP(H, WS_H); WSP(WIN, WS_WIN); WSP(AK, WS_AK); WSP(AV, WS_AV); WSP(LFF, WS_LFF); WSP(LFB, WS_LFB); WSP(RI, WS_RI); WSP(RQ, WS_RQ); WSP(AQ, WS_AQ); WSP(RG, WS_RG); u16* GATES = (u16*)p.out;
  {
    pg8::Gemm g{H, WIN, MALL, NIN, DM, DM}; pg8::OrderIn S; S.init(G, bx);
    pg8::EpiIn E{AK, AV, LFF, LFB, RI, AQ, RQ, RG, GATES, ctl + C_LBF, ctl + C_LBB, ctl + C_COS, ctl + C_SIN};
#ifdef PROBE_EPINONE
    if (rep == 1) { pg8::EpiNone EN{(float*)(ws + WS_CTL) + 200000}; pg8::gemm_phase<pg8::EpiNone, pg8::OrderIn, true, true>(glds, g, S, EN); } else
#endif
    pg8::gemm_phase<pg8::EpiIn, pg8::OrderIn, true, true>(glds, g, S, E);
    const int tf_ = (G > 160) ? 160 : 0;
    if (bx >= tf_) {
      __syncthreads();
      float* scr = (float*)(lds + wave * 16384);
      constexpr int I_BA = 16 * 64, I_OUT = 32 * 64, I_DN = 88 * 64, NIT2 = 2 * I_BA + I_OUT + I_DN;
      WSP(WBA, WS_WBA); WSP(WBR, WS_WBR); WSP(WOUT, WS_WOUT); WSP(WDN, WS_WDN);
      for (int it = (bx - tf_) * 8 + wave; it < NIT2; it += (G - tf_) * 8) {
        int r = it;
        if (r < I_BA) { transpose_item(p.w_branch_attn, 1024, DM, WBA, scr, r, lane, false); continue; } r -= I_BA;
        if (r < I_BA) { transpose_item(p.w_branch_rec, 1024, DM, WBR, scr, r, lane, false); continue; } r -= I_BA;
        if (r < I_OUT) { transpose_item(p.w_out, DM, DM, WOUT, scr, r, lane, false); continue; } r -= I_OUT;
        transpose_item(p.w_down, FF, DM, WDN, scr, r, lane, false);
      }
    }
  }
  }
  FAST_SYNC();
  }
  _Pragma("unroll") for (int rep = 0; rep <= ((DUP_MASK >> 3) & 1); ++rep) {
  if (PHASES & (1 << 3)) {
  PHASE_BEGIN() WSP(AK, WS_AK); WSP(AV, WS_AV); WSP(LFF, WS_LFF); WSP(LFB, WS_LFB); WSP(RI, WS_RI); WSP(RQ, WS_RQ); WSP(AQ, WS_AQ); WSP(ATT, WS_ATT); WSP(OF, WS_OF); WSP(OB, WS_OB); WSP(RG, WS_RG);
  {
#ifndef NO_SCAN
#ifdef PROBE_ATTONLY
    if (rep == 0)
#endif
    if (bx < 128) { const int b = bx >> 4, h = (bx >> 1) & 7, dir = bx & 1;
#ifdef PROBE_SCANVAR
      if (rep == 1) scan_item<PROBE_SCANVAR>(b, h, dir, dir ? LFB : LFF, RI, RQ, (u16*)(ws + 196 * MiB), lds); else
#endif
      scan_item<0>(b, h, dir, dir ? LFB : LFF, RI, RQ, dir ? OB : OF, lds);
      asm volatile("s_waitcnt vmcnt(0)" ::: "memory"); __syncthreads();
      if (tid == 0) { __builtin_amdgcn_fence(__ATOMIC_RELEASE, "agent"); asm volatile("s_waitcnt vmcnt(0)" ::: "memory");
        (void)__hip_atomic_fetch_add((unsigned*)(ctl + C_CTR) + 1024, 1u, __ATOMIC_RELAXED, __HIP_MEMORY_SCOPE_AGENT); } }
#endif
#ifndef NO_ATT
#ifdef PROBE_SCANONLY
    if (rep == 0)
#endif
    {
    const float lam = ctl[C_LAM];
    const unsigned xcc = (unsigned)__builtin_amdgcn_s_getreg((3 << 11) | 20) & 7u;
    for (int qi = 0; qi < 8; ++qi) {
      const unsigned q = (xcc + (unsigned)qi) & 7u;
      unsigned* ctr = (unsigned*)(ctl + C_CTR) + 512 * rep + 32 * q;
      for (;;) {
        if (tid == 0) *(volatile unsigned*)(lds + ATT_CTR) = atomicAdd(ctr, 1u);
        __syncthreads();
        const unsigned u = *(volatile unsigned*)(lds + ATT_CTR);
        __syncthreads();
        if (u >= 128u) break;
        const int b = (int)q, h = (int)(u >> 4), qb = (int)(u & 15u);
#ifdef PROBE_ATTVAR
        if (rep == 1) attn_unit<PROBE_ATTVAR>(AQ + ((size_t)b * SEQ + qb * 128) * 1024 + h * 128, (u16*)(ws + 196 * MiB) + (size_t)(qb & 7) * 128 * 1024 + h * 128, AK + (size_t)b * TKV * 1024 + h * 128, AV + (size_t)b * TKV * 1024 + h * 128, lam, p.subln_w, lds); else
#endif
        attn_unit<0>(AQ + ((size_t)b * SEQ + qb * 128) * 1024 + h * 128, ATT + ((size_t)b * SEQ + qb * 128) * 1024 + h * 128, AK + (size_t)b * TKV * 1024 + h * 128, AV + (size_t)b * TKV * 1024 + h * 128, lam, p.subln_w, lds);
      }
    }
    }
#endif
    { unsigned* sdone = (unsigned*)(ctl + C_CTR) + 1024; unsigned* rq = (unsigned*)(ctl + C_CTR) + 1056;
      if (tid == 0) { unsigned sp = 0u;
        while (__hip_atomic_load(sdone, __ATOMIC_RELAXED, __HIP_MEMORY_SCOPE_AGENT) < 128u) { __builtin_amdgcn_s_sleep(8); if (++sp > (1u << 20)) break; }
        __builtin_amdgcn_fence(__ATOMIC_ACQUIRE, "agent"); asm volatile("s_waitcnt vmcnt(0)" ::: "memory"); }
      __syncthreads();
      for (;;) {
        if (tid == 0) *(volatile unsigned*)(lds + ATT_CTR) = atomicAdd(rq, 1u);
        __syncthreads();
        const unsigned it = *(volatile unsigned*)(lds + ATT_CTR);
        __syncthreads();
        if (it >= 256u) break;
#pragma unroll 1
        for (int i = 0; i < 8; ++i) rec_readout_row(OF, OB, RG, p.rec_gnorm_w, (int)it * 64 + wave * 8 + i, lane);
      } }
  }
  }
  FAST_SYNC();
  }
  _Pragma("unroll") for (int rep = 0; rep <= ((DUP_MASK >> 5) & 1); ++rep) {
  if (PHASES & (1 << 5)) {
  PHASE_BEGIN() WSP(ATT, WS_ATT); WSP(RG, WS_RG); WSP(WBA, WS_WBA); WSP(WBR, WS_WBR); WSP(Y, WS_Y); u16* T = (u16*)(ws + WS_T); u16* GATES = (u16*)p.out;
  {
    pg8::StaticOrder S; S.init(MTOK, DM, G, bx);
    { pg8::Gemm g{ATT, WBA, MTOK, DM, 1024, 1024}; pg8::EpiMergeA E{GATES, T}; pg8::gemm_phase<pg8::EpiMergeA, pg8::StaticOrder, true, true>(glds, g, S, E); }
    __syncthreads();
    { pg8::Gemm g{RG, WBR, MTOK, DM, 1024, 1024}; pg8::EpiMergeB E{GATES, T, Y}; pg8::gemm_phase<pg8::EpiMergeB, pg8::StaticOrder, true, true>(glds, g, S, E); }
  }
  }
  FAST_SYNC();
  }
  _Pragma("unroll") for (int rep = 0; rep <= ((DUP_MASK >> 6) & 1); ++rep) {
  if (PHASES & (1 << 6)) {
  PHASE_BEGIN() WSP(Y, WS_Y); WSP(WOUT, WS_WOUT);
  {
    pg8::StaticOrder S; S.init(MTOK, DM, G, bx);
    pg8::Gemm g{Y, WOUT, MTOK, DM, DM, DM}; pg8::EpiRes E{p.x, p.out, mod + 4096};
    pg8::gemm_phase<pg8::EpiRes, pg8::StaticOrder, true, true>(glds, g, S, E);
  }
  }
  FAST_SYNC();
  }
  _Pragma("unroll") for (int rep = 0; rep <= ((DUP_MASK >> 7) & 1); ++rep) {
  if (PHASES & (1 << 7)) {
  PHASE_BEGIN() WSP(H2, WS_H2);
  for (int m = gw; m < MTOK; m += NGW) { const float* mr = mod + (size_t)(m >> 11) * NIN; norm_mod_row(p.out + (size_t)m * DM, p.norm2_w, mr + 8192, mr + 6144, H2 + (size_t)m * DM, lane); }
  }
  FAST_SYNC();
  }
  _Pragma("unroll") for (int rep = 0; rep <= ((DUP_MASK >> 8) & 1); ++rep) {
  if (PHASES & (1 << 8)) {
  PHASE_BEGIN() WSP(H2, WS_H2); WSP(WUP, WS_WUP); WSP(U, WS_U); WSP(SIDE, WS_SIDE);
  {
    pg8::StaticOrder so; so.init(MTOK, FF2, G, bx);
    pg8::Gemm g{H2, WUP, MTOK, FF2, DM, DM}; pg8::EpiConv E{U, SIDE, p.conv_w, p.conv_b};
    pg8::Unit uu;
    for (int i = 0; so.next(i, uu); ++i) { pg8::OneUnit S1{uu}; pg8::gemm_phase<pg8::EpiConv, pg8::OneUnit, false, true>(glds, g, S1, E); }
  }
  }
  FAST_SYNC();
  }
  _Pragma("unroll") for (int rep = 0; rep <= ((DUP_MASK >> 9) & 1); ++rep) {
  if (PHASES & (1 << 9)) {
  PHASE_BEGIN() WSP(U, WS_U); WSP(SIDE, WS_SIDE);
  for (int it = gw; it < 64 * 2 * 11; it += NGW) {
    const int pg = it % 11, which = (it / 11) & 1, pm = it / 22;
    const int pn = pg * 4 + (lane >> 4), c8 = lane & 15, f = pn * 128 + c8 * 8;
    const bool edge = which == 0 ? ((pm & 7) == 0) : ((pm & 7) == 7);
    float wa[3][8], wb[3][8], ba[8], bb[8];
#pragma unroll
    for (int j = 0; j < 3; ++j)
#pragma unroll
      for (int i = 0; i < 8; ++i) { wa[j][i] = p.conv_w[j * FF2 + f + i]; wb[j][i] = p.conv_w[j * FF2 + FF + f + i]; }
#pragma unroll
    for (int i = 0; i < 8; ++i) { ba[i] = p.conv_b[f + i]; bb[i] = p.conv_b[FF + f + i]; }
    const u32x4v z = {0u, 0u, 0u, 0u};
    const u16* s_own = SIDE + ((size_t)(pm * 44 + pn) * 4) * 256;
    u32x4v pa, pb, ca, cb, na, nb;
    if (which == 0) {
      if (edge) { pa = z; pb = z; } else { const u16* sp = SIDE + ((size_t)((pm - 1) * 44 + pn) * 4 + 3) * 256; pa = *(const u32x4v*)(sp + c8 * 8); pb = *(const u32x4v*)(sp + 128 + c8 * 8); }
      ca = *(const u32x4v*)(s_own + c8 * 8); cb = *(const u32x4v*)(s_own + 128 + c8 * 8);
      na = *(const u32x4v*)(s_own + 256 + c8 * 8); nb = *(const u32x4v*)(s_own + 256 + 128 + c8 * 8);
    } else {
      pa = *(const u32x4v*)(s_own + 512 + c8 * 8); pb = *(const u32x4v*)(s_own + 512 + 128 + c8 * 8);
      ca = *(const u32x4v*)(s_own + 768 + c8 * 8); cb = *(const u32x4v*)(s_own + 768 + 128 + c8 * 8);
      if (edge) { na = z; nb = z; } else { const u16* sp = SIDE + ((size_t)((pm + 1) * 44 + pn) * 4 + 0) * 256; na = *(const u32x4v*)(sp + c8 * 8); nb = *(const u32x4v*)(sp + 128 + c8 * 8); }
    }
    u32x4v o;
#pragma unroll
    for (int i = 0; i < 4; ++i) {
      const float a0 = ba[2 * i] + wa[0][2 * i] * bflo(pa[i]) + wa[1][2 * i] * bflo(ca[i]) + wa[2][2 * i] * bflo(na[i]);
      const float a1 = ba[2 * i + 1] + wa[0][2 * i + 1] * bfhi(pa[i]) + wa[1][2 * i + 1] * bfhi(ca[i]) + wa[2][2 * i + 1] * bfhi(na[i]);
      const float b0 = bb[2 * i] + wb[0][2 * i] * bflo(pb[i]) + wb[1][2 * i] * bflo(cb[i]) + wb[2][2 * i] * bflo(nb[i]);
      const float b1 = bb[2 * i + 1] + wb[0][2 * i + 1] * bfhi(pb[i]) + wb[1][2 * i + 1] * bfhi(cb[i]) + wb[2][2 * i + 1] * bfhi(nb[i]);
      o[i] = cvtpk(silu_(a0) * b0, silu_(a1) * b1); }
    *(u32x4v*)(U + (size_t)(pm * 256 + (which ? 255 : 0)) * FF + f) = o;
  }
  }
  FAST_SYNC();
  }
  _Pragma("unroll") for (int rep = 0; rep <= ((DUP_MASK >> 10) & 1); ++rep) {
  if (PHASES & (1 << 10)) {
  PHASE_BEGIN() WSP(U, WS_U); WSP(WDN, WS_WDN);
  {
    pg8::StaticOrder S; S.init(MTOK, DM, G, bx);
    pg8::Gemm g{U, WDN, MTOK, DM, FF, FF};
    if (G == 256) {
      pg8::EpiResFinal E{p.out, p.out, mod + 10240, p.final_norm_w, (float*)(ws + WS_PART), (unsigned*)(ws + WS_CTL) + C_CNTP};
      pg8::gemm_phase<pg8::EpiResFinal, pg8::StaticOrder, true, true>(glds, g, S, E);
    } else {
      pg8::EpiRes E{p.out, p.out, mod + 10240};
      pg8::gemm_phase<pg8::EpiRes, pg8::StaticOrder, true, true>(glds, g, S, E);
    }
  }
  }
  if (gridDim.x != 256) FAST_SYNC();
  }
  _Pragma("unroll") for (int rep = 0; rep <= ((DUP_MASK >> 11) & 1); ++rep) {
  if (PHASES & (1 << 11)) {
  PHASE_BEGIN()
  if (G != 256)
  for (int m = gw; m < MTOK; m += NGW) {
    f32x4v* xr = (f32x4v*)(p.out + (size_t)m * DM) + lane; f32x4v v[8]; float s = 0.f;
#pragma unroll
    for (int j = 0; j < 8; ++j) { v[j] = xr[64 * j]; s += (v[j].x * v[j].x + v[j].y * v[j].y) + (v[j].z * v[j].z + v[j].w * v[j].w); }
    const float rstd = rsqrtf(wave_sum(s) * (1.f / DM) + EPS);
#pragma unroll
    for (int j = 0; j < 8; ++j) { const f32x4v w = *(const f32x4v*)(p.final_norm_w + 4 * (lane + 64 * j)); xr[64 * j] = v[j] * rstd * w; }
  }
  }
  }
}

extern "C" void kernel_launch(void* const* d_in, const int* in_sizes, int n_in, void* d_out, int out_size, void* d_ws, size_t ws_size, hipStream_t stream) {
  static int grid = 0;
  if (grid == 0) {
    if (n_in != 24 || in_sizes[0] != MTOK * DM || out_size != MTOK * DM || ws_size < WS_END) {
      fprintf(stderr, "kernel_launch: unexpected shapes: n_in %d in0 %d out %d ws %zu (need >= %zu)\n", n_in, n_in > 0 ? in_sizes[0] : -1, out_size, ws_size, (size_t)WS_END); grid = -1; return; }
    int dev = 0, cus = 0, per_cu = 0;
    if (hipGetDevice(&dev) != hipSuccess || hipDeviceGetAttribute(&cus, hipDeviceAttributeMultiprocessorCount, dev) != hipSuccess) { grid = -1; return; }
    if (hipFuncSetAttribute((const void*)fwd_megakernel, hipFuncAttributeMaxDynamicSharedMemorySize, LDS_BYTES) != hipSuccess) { fprintf(stderr, "kernel_launch: hipFuncSetAttribute failed\n"); grid = -1; return; }
    if (hipOccupancyMaxActiveBlocksPerMultiprocessor(&per_cu, (const void*)fwd_megakernel, 512, LDS_BYTES) != hipSuccess || per_cu < 1) { fprintf(stderr, "kernel_launch: occupancy query says %d\n", per_cu); }
    (void)hipGetLastError();
    grid = cus;
    if (grid != 256) fprintf(stderr, "kernel_launch: note: %d CUs\n", grid);
  }
  if (grid < 0) return;
  (void)hipMemsetAsync((char*)d_ws + WS_CTL, 0, CTL_ZERO_BYTES, stream);
  Params p{};
  const float** pp = (const float**)&p;
  for (int i = 0; i < 24; ++i) pp[i] = (const float*)d_in[i];
  p.out = (float*)d_out; p.ws = (unsigned char*)d_ws;
  void* args[] = {&p};
  hipError_t e = hipLaunchCooperativeKernel((const void*)fwd_megakernel, dim3(grid), dim3(512), args, LDS_BYTES, stream);
  if (e != hipSuccess) fprintf(stderr, "kernel_launch: cooperative launch failed: %s (grid %d)\n", hipGetErrorString(e), grid);
}
```

```cpp
#include <hip/hip_runtime.h>
#include <hip/hip_cooperative_groups.h>
#include <cstdio>
#include <cstdint>
namespace cg = cooperative_groups;
#define DI __device__ __forceinline__
#define LAS __attribute__((address_space(3)))
typedef unsigned short u16;
typedef float f32x2 __attribute__((ext_vector_type(2)));
typedef float f32x4v __attribute__((ext_vector_type(4)));
typedef float f32x16 __attribute__((ext_vector_type(16)));
typedef short s16x8 __attribute__((ext_vector_type(8)));
typedef short s16x4 __attribute__((ext_vector_type(4)));
typedef unsigned u32x4v __attribute__((ext_vector_type(4)));
typedef unsigned u32x2v __attribute__((ext_vector_type(2)));
typedef __bf16 bf16x2_t __attribute__((ext_vector_type(2)));
typedef _Float16 h16x2_t __attribute__((ext_vector_type(2)));

constexpr int DM = 2048, NB = 8, SEQ = 2048, MTOK = NB * SEQ, CTXL = 256, MCTX = NB * CTXL, MALL = MTOK + MCTX;
constexpr int NIN = 12288, TKV = SEQ + CTXL  , FF = 5632, FF2 = 2 * FF;
constexpr float EPS = 1e-6f;
constexpr size_t MiB = 1u << 20;
constexpr size_t WS_CTL = 0, WS_WUP = 2 * MiB, WS_WDN = 46 * MiB, WS_SIDE = 68 * MiB, WS_H2 = 91 * MiB, WS_U = 155 * MiB, WS_END = 507 * MiB;
constexpr size_t WS_WIN = 68 * MiB, WS_WBA = 116 * MiB, WS_WBR = 120 * MiB, WS_WOUT = 124 * MiB, WS_H = 132 * MiB, WS_OF = 132 * MiB, WS_OB = 164 * MiB;
constexpr size_t WS_AK = 204 * MiB, WS_AV = 240 * MiB, WS_LFF = 276 * MiB, WS_LFB = 312 * MiB, WS_RI = 348 * MiB, WS_RQ = 384 * MiB, WS_AQ = 416 * MiB, WS_RG = 448 * MiB;
constexpr size_t WS_T = 204 * MiB, WS_Y = 348 * MiB, WS_ATT = 68 * MiB;
constexpr int C_MOD = 0, C_LAM = 110592, C_LBF = 110608, C_LBB = 111632, C_COS = 112656, C_SIN = 113680, C_CTR = 114704;
constexpr size_t CTL_ZERO_BYTES = 1 * MiB;
constexpr int LDS_BYTES = 147456, XB_LDS_OFF = LDS_BYTES - 64;
constexpr int C_BAR = 131072;

DI unsigned cvtpk(float lo, float hi) { f32x2 v = {lo, hi}; bf16x2_t b = __builtin_convertvector(v, bf16x2_t); return __builtin_bit_cast(unsigned, b); }
DI unsigned cvtpk_h(float lo, float hi) { f32x2 v = {lo, hi}; h16x2_t b = __builtin_convertvector(v, h16x2_t); return __builtin_bit_cast(unsigned, b); }
DI float bf2f(u16 b) { return __uint_as_float((unsigned)b << 16); }
DI float bflo(unsigned w) { return __uint_as_float(w << 16); }
DI float bfhi(unsigned w) { return __uint_as_float(w & 0xffff0000u); }
DI u16 f2bf(float f) { return (u16)(cvtpk(f, 0.f) & 0xffffu); }
DI float h2f(u16 h) { return (float)__builtin_bit_cast(_Float16, h); }
DI float fexp(float x) { return __builtin_amdgcn_exp2f(x * 1.4426950408889634f); }
DI float sigm(float x) { return __builtin_amdgcn_rcpf(1.f + fexp(-x)); }
DI float silu_(float x) { return x * sigm(x); }
DI float wave_sum(float v) {
#pragma unroll
  for (int o = 1; o < 64; o <<= 1) v += __shfl_xor(v, o);
  return v;
}
#define LDS_WAIT() asm volatile("s_waitcnt lgkmcnt(0)" ::: "memory")

namespace pg8 {
#define PG8_LAS __attribute__((address_space(3)))
typedef unsigned short bf16_t;
typedef short bf16x8 __attribute__((ext_vector_type(8)));
typedef float f32x4 __attribute__((ext_vector_type(4)));
typedef unsigned u32x4 __attribute__((ext_vector_type(4)));
constexpr int BM = 256, BK = 64, HALF = 128, HTB = HALF * BK * 2  , STAGE_BYTES = 8 * HTB, NXCD = 8, WGM = 4;

__host__ __device__ __forceinline__ int lds_byte(int r, int c) { const int st = (r >> 4) * 2 + (c >> 5), rr = r & 15, cc = c & 31, ob = rr * 64 + cc * 2; return st * 1024 + (ob ^ (((ob >> 9) & 1) << 5)); }
__host__ __device__ __forceinline__ void stage_rc(int b, int& R, int& C) { const int st = b / 1024, sb = b % 1024, swz = sb ^ (((sb >> 9) & 1) << 5); R = (st >> 1) * 16 + swz / 64; C = (st & 1) * 32 + (swz % 64) / 2; }
__host__ __device__ __forceinline__ int perm32(int rho) { const int n = rho >> 4, i = rho & 15; return 8 * (i >> 2) + 4 * n + (i & 3); }

struct Unit { int pm, pn; };
struct Gemm { const bf16_t* A; const bf16_t* Bt; int M, N, K, lda; };

struct StaticOrder {
    int nM, nN, nwg, G, c;
    __host__ __device__ void init(int M, int N, int G_, int c_) { nM = M / BM; nN = N / BM; nwg = nM * nN; G = G_; c = c_; }
    __host__ __device__ bool next(int i, Unit& u) const {
        const long L = (long)i * G + c; if (L >= nwg) return false;
        int wgid = (int)L; { const int q = nwg / NXCD, r = nwg % NXCD, xcd = wgid % NXCD, off = wgid / NXCD; wgid = (xcd < r ? xcd * (q + 1) : r * (q + 1) + (xcd - r) * q) + off; }
        const int nig = WGM * nN, gid = wgid / nig, fm = gid * WGM, gsz = (nM - fm) < WGM ? (nM - fm) : WGM;
        u.pm = fm + ((wgid % nig) % gsz); u.pn = (wgid % nig) / gsz; return true;
    }
    __device__ __forceinline__ void a_ready(const Unit&) const {}
    __device__ __forceinline__ void done(const Unit&) const {}
};
typedef PG8_LAS unsigned char* LdsPtr;
__device__ __forceinline__ unsigned cvt_pk_bf16(float lo, float hi) { return cvtpk(lo, hi); }
template <class Epi, class Sched, bool ALIGN_EPI = false, bool SP2 = false>
__device__ __forceinline__ void gemm_phase(PG8_LAS unsigned char* lds, const Gemm g, const Sched& S, const Epi& E) {
    int tid_ = threadIdx.x; asm volatile("" : "+v"(tid_)); const int tid = tid_, wid = __builtin_amdgcn_readfirstlane(tid >> 6), lane = tid & 63, wr = wid >> 2, wc = wid & 3, fr = lane & 15, fq = lane >> 4;
    const int K = g.K, nt = K / BK;
    unsigned voffA[2], voffB[2];
#pragma unroll
    for (int i = 0; i < 2; ++i) { int R, C; stage_rc(tid * 16 + i * 8192, R, C); const int Rb = Epi::PERM ? ((R & ~31) + perm32(R & 31)) : R;
        voffA[i] = (unsigned)(R * g.lda + C) * 2u; voffB[i] = (unsigned)(Rb * K + C) * 2u; }
    const size_t kstep = (size_t)(BK * 2);
    const size_t hstepA = (size_t)HALF * g.lda * 2, hstepB = (size_t)HALF * K * 2;
    const size_t tstepA = 2 * hstepA, tstepB = 2 * hstepB;
    const unsigned ldsw = (unsigned)wid * 1024u;
    const int aoff = lds_byte(wr * 64 + fr, fq * 8), boff = lds_byte(wc * 32 + fr, fq * 8);
#define PG8_SA(b, h) (((b) * 2 + (h)) * HTB)
#define PG8_SB(b, h) ((4 + (b) * 2 + (h)) * HTB)
#define PG8_STAGE(bufoff, gbase, voff) do { _Pragma("unroll") for (int _i = 0; _i < 2; ++_i) \
        __builtin_amdgcn_global_load_lds((const unsigned*)((const char*)(gbase) + (voff)[_i]), (PG8_LAS unsigned*)(lds + (bufoff) + ldsw + _i * 8192), 16, 0, 0); } while (0)
#define PG8_LDA(dst, b, h) do { _Pragma("unroll") for (int m = 0; m < 4; ++m) _Pragma("unroll") for (int k = 0; k < 2; ++k) dst[m][k] = *(const PG8_LAS bf16x8*)(lds + PG8_SA(b, h) + aoff + m * 2048 + k * 1024); } while (0)
#define PG8_LDB(dst, b, h) do { _Pragma("unroll") for (int n = 0; n < 2; ++n) _Pragma("unroll") for (int k = 0; k < 2; ++k) dst[n][k] = *(const PG8_LAS bf16x8*)(lds + PG8_SB(b, h) + boff + n * 2048 + k * 1024); } while (0)
#define PG8_MMA(ai, bj, At, Bt) do { __builtin_amdgcn_s_setprio(1); _Pragma("unroll") for (int m = 0; m < 4; ++m) _Pragma("unroll") for (int n = 0; n < 2; ++n) _Pragma("unroll") for (int k = 0; k < 2; ++k) \
        acc[ai][bj][m][n] = __builtin_amdgcn_mfma_f32_16x16x32_bf16(Bt[n][k], At[m][k], acc[ai][bj][m][n], 0, 0, 0); __builtin_amdgcn_s_setprio(0); } while (0)
#define PG8_WAIT_V(n) asm volatile("s_waitcnt vmcnt(" #n ")" ::: "memory")
#define PG8_WAIT_L(n) asm volatile("s_waitcnt lgkmcnt(" #n ")" ::: "memory")
#define PG8_BAR __builtin_amdgcn_s_barrier()
#define PG8_SCHED __builtin_amdgcn_sched_barrier(0)
    Unit cur, nxt; int ui = 0;
    if (!S.next(0, cur)) return;
    f32x4 acc[2][2][4][2];
#pragma unroll
    for (int a = 0; a < 2; ++a)
#pragma unroll
        for (int b = 0; b < 2; ++b)
#pragma unroll
            for (int m = 0; m < 4; ++m)
#pragma unroll
                for (int n = 0; n < 2; ++n) acc[a][b][m][n] = (f32x4){0.f, 0.f, 0.f, 0.f};
    bf16x8 At[4][2], B0[2][2], B1[2][2];
    const char* cA = (const char*)g.A + (size_t)cur.pm * tstepA; const char* cB = (const char*)g.Bt + (size_t)cur.pn * tstepB;
    S.a_ready(cur);
    if constexpr (SP2) {
        PG8_STAGE(PG8_SB(0, 0), cB, voffB); PG8_STAGE(PG8_SB(0, 1), cB + hstepB, voffB); PG8_STAGE(PG8_SA(0, 0), cA, voffA); PG8_STAGE(PG8_SA(0, 1), cA + hstepA, voffA);
        if (wr == 1) PG8_BAR;
        PG8_WAIT_V(2); PG8_BAR;
        PG8_STAGE(PG8_SB(1, 0), cB + kstep, voffB); PG8_STAGE(PG8_SA(1, 0), cA + kstep, voffA); PG8_STAGE(PG8_SB(1, 1), cB + hstepB + kstep, voffB);
        PG8_WAIT_V(6); PG8_BAR;
    } else {
        PG8_STAGE(PG8_SB(0, 0), cB, voffB); PG8_STAGE(PG8_SA(0, 0), cA, voffA); PG8_STAGE(PG8_SB(0, 1), cB + hstepB, voffB); PG8_STAGE(PG8_SA(0, 1), cA + hstepA, voffA);
        if (wr == 1) PG8_BAR;
        PG8_WAIT_V(4); PG8_BAR;
        PG8_STAGE(PG8_SB(1, 0), cB + kstep, voffB); PG8_STAGE(PG8_SA(1, 0), cA + kstep, voffA); PG8_STAGE(PG8_SB(1, 1), cB + hstepB + kstep, voffB);
        PG8_WAIT_V(6); PG8_BAR;
    }
    for (;;) {
        const bool has_next = S.next(ui + 1, nxt);
        const char* nA = has_next ? (const char*)g.A + (size_t)nxt.pm * tstepA : cA; const char* nB = has_next ? (const char*)g.Bt + (size_t)nxt.pn * tstepB : cB;
        for (int t = 0; t < nt; t += 2) {
            const bool last = (t == nt - 2);
            const char* a1 = cA + (size_t)(t + 1) * kstep;
            const char* a2 = last ? nA : cA + (size_t)(t + 2) * kstep; const char* b2 = last ? nB : cB + (size_t)(t + 2) * kstep;
            const char* a3 = a2 + kstep; const char* b3 = b2 + kstep;
            if (last && has_next) S.a_ready(nxt);
            if constexpr (SP2) {
            PG8_LDB(B0, 0, 0); PG8_LDB(B1, 0, 1); PG8_SCHED; PG8_LDA(At, 0, 0); PG8_STAGE(PG8_SA(1, 1), a1 + hstepA, voffA);
            PG8_WAIT_V(8); PG8_WAIT_L(0); PG8_BAR; PG8_MMA(0, 0, At, B0); PG8_MMA(0, 1, At, B1); PG8_BAR; PG8_SCHED;
            PG8_LDA(At, 0, 1); PG8_STAGE(PG8_SB(0, 0), b2, voffB); PG8_STAGE(PG8_SB(0, 1), b2 + hstepB, voffB); PG8_STAGE(PG8_SA(0, 0), a2, voffA);
            PG8_WAIT_V(8); PG8_WAIT_L(0); PG8_BAR; PG8_MMA(1, 0, At, B0); PG8_MMA(1, 1, At, B1); PG8_BAR; PG8_SCHED;
            PG8_LDB(B0, 1, 0); PG8_LDB(B1, 1, 1); PG8_SCHED; PG8_LDA(At, 1, 0); PG8_STAGE(PG8_SA(0, 1), a2 + hstepA, voffA);
            PG8_WAIT_V(8); PG8_WAIT_L(0); PG8_BAR; PG8_MMA(0, 0, At, B0); PG8_MMA(0, 1, At, B1); PG8_BAR; PG8_SCHED;
            PG8_LDA(At, 1, 1); PG8_STAGE(PG8_SB(1, 0), b3, voffB); PG8_STAGE(PG8_SB(1, 1), b3 + hstepB, voffB); PG8_STAGE(PG8_SA(1, 0), a3, voffA);
            PG8_WAIT_V(8); PG8_WAIT_L(0); PG8_BAR; PG8_MMA(1, 0, At, B0); PG8_MMA(1, 1, At, B1); PG8_BAR; PG8_SCHED;
            } else {
            PG8_LDB(B0, 0, 0); PG8_SCHED; PG8_LDA(At, 0, 0); PG8_STAGE(PG8_SA(1, 1), a1 + hstepA, voffA);
            PG8_WAIT_L(8); PG8_BAR; PG8_WAIT_L(0); PG8_MMA(0, 0, At, B0); PG8_BAR; PG8_SCHED;
            PG8_LDB(B1, 0, 1); PG8_STAGE(PG8_SB(0, 0), b2, voffB);
            PG8_BAR; PG8_WAIT_L(0); PG8_MMA(0, 1, At, B1); PG8_BAR;
            PG8_LDA(At, 0, 1); PG8_STAGE(PG8_SA(0, 0), a2, voffA);
            PG8_BAR; PG8_WAIT_L(0); PG8_MMA(1, 0, At, B0); PG8_BAR; PG8_SCHED;
            PG8_STAGE(PG8_SB(0, 1), b2 + hstepB, voffB);
            PG8_WAIT_V(6); PG8_BAR; PG8_MMA(1, 1, At, B1); PG8_BAR;
            PG8_LDB(B0, 1, 0); PG8_SCHED; PG8_LDA(At, 1, 0); PG8_STAGE(PG8_SA(0, 1), a2 + hstepA, voffA);
            PG8_WAIT_L(8); PG8_BAR; PG8_WAIT_L(0); PG8_MMA(0, 0, At, B0); PG8_BAR; PG8_SCHED;
            PG8_LDB(B1, 1, 1); PG8_STAGE(PG8_SB(1, 0), b3, voffB);
            PG8_BAR; PG8_WAIT_L(0); PG8_MMA(0, 1, At, B1); PG8_BAR;
            PG8_LDA(At, 1, 1); PG8_STAGE(PG8_SA(1, 0), a3, voffA);
            PG8_BAR; PG8_WAIT_L(0); PG8_MMA(1, 0, At, B0); PG8_BAR; PG8_SCHED;
            PG8_STAGE(PG8_SB(1, 1), b3 + hstepB, voffB);
            PG8_WAIT_V(6); PG8_BAR; PG8_MMA(1, 1, At, B1); PG8_BAR;
            }
        }
        if constexpr (ALIGN_EPI) { if (wr == 0) PG8_BAR; }
        if constexpr (!Epi::AFTER_DRAIN) { E(acc, cur, wr, wc, fr, fq); S.done(cur); }
        if (!has_next) break;
#pragma unroll
        for (int a = 0; a < 2; ++a)
#pragma unroll
            for (int b = 0; b < 2; ++b)
#pragma unroll
                for (int m = 0; m < 4; ++m)
#pragma unroll
                    for (int n = 0; n < 2; ++n) acc[a][b][m][n] = (f32x4){0.f, 0.f, 0.f, 0.f};
        cur = nxt; cA = nA; cB = nB; ++ui;
        if constexpr (ALIGN_EPI) { if (wr == 1) PG8_BAR; }
    }
    PG8_WAIT_V(0);
    if constexpr (!ALIGN_EPI) { if (wr == 0) PG8_BAR; }
    PG8_BAR;
    if constexpr (Epi::AFTER_DRAIN) { E.fused(acc, cur, wr, wc, fr, fq, lds, wid, lane); S.done(cur); }
#undef PG8_SA
#undef PG8_SB
#undef PG8_STAGE
#undef PG8_LDA
#undef PG8_LDB
#undef PG8_MMA
#undef PG8_WAIT_V
#undef PG8_WAIT_L
#undef PG8_BAR
#undef PG8_SCHED
}
struct OrderIn {
    StaticOrder so; int G, c;
    __device__ void init(int G_, int c_) { so.init(16384, 12288, G_, c_); G = G_; c = c_; }
    __device__ bool next(int i, Unit& u) const {
        if (so.next(i, u)) return true;
        const long L = (long)i * G + c - 3072; if (L < 0 || L >= 160) return false;
        u.pm = 64 + (int)(L & 7); u.pn = (int)(L >> 3); return true;
    }
    __device__ __forceinline__ void a_ready(const Unit&) const {}
    __device__ __forceinline__ void done(const Unit&) const {}
};

struct EpiIn {
    static constexpr bool PERM = true, AFTER_DRAIN = false;
    u16 *AK, *AV, *LFF, *LFB, *RI, *AQ, *RQ, *RG, *GATES; const float *lbf, *lbb, *rcos, *rsin;
    template <int MODE> __device__ __forceinline__ void run(const f32x4 (&acc)[2][2][4][2], u16* dst, int ld, int row0, int col0, int trow0, int wc, int fq, const float* lb) const {
        f32x4 lb0[2], lb1[2];
        if (MODE == 3) {
#pragma unroll
            for (int bj = 0; bj < 2; ++bj) { lb0[bj] = *(const f32x4*)(lb + col0 + bj * HALF); lb1[bj] = *(const f32x4*)(lb + col0 + bj * HALF + 4); }
        }
#pragma unroll
        for (int ai = 0; ai < 2; ++ai)
#pragma unroll
            for (int m = 0; m < 4; ++m) {
                const int rr = ai * HALF + m * 16;
                u16* rowp = dst + (size_t)(row0 + rr) * ld + col0;
                f32x4 cs, sn;
                if (MODE == 1 || MODE == 2) { const int t = trow0 + rr; const int pos = (wc & 1) ? (t & 63) : (t >> 6);
                    cs = *(const f32x4*)(rcos + pos * 16 + 4 * fq); sn = *(const f32x4*)(rsin + pos * 16 + 4 * fq); }
#pragma unroll
                for (int bj = 0; bj < 2; ++bj) {
                    f32x4 v0 = acc[ai][bj][m][0], v1 = acc[ai][bj][m][1];
                    if (MODE == 1 || MODE == 2) { const f32x4 a = v0 * cs - v1 * sn, b = v1 * cs + v0 * sn; v0 = a; v1 = b;
                        if (MODE == 2) { v0 = v0 * 0.18033688011112042f; v1 = v1 * 0.18033688011112042f; } }
                    if (MODE == 3) {
#pragma unroll
                        for (int i = 0; i < 4; ++i) { const float l0 = lb0[bj][i], l1 = lb1[bj][i];
                            v0[i] = __logf(l0 + (1.f - l0) * sigm(v0[i])); v1[i] = __logf(l1 + (1.f - l1) * sigm(v1[i])); }
                    }
                    if (MODE == 4) {
#pragma unroll
                        for (int i = 0; i < 4; ++i) { v0[i] = silu_(v0[i]); v1[i] = silu_(v1[i]); }
                    }
                    if (MODE == 5) {
#pragma unroll
                        for (int i = 0; i < 4; ++i) { v0[i] = sigm(v0[i]); v1[i] = sigm(v1[i]); }
                    }
                    u32x4 w;
                    if (MODE == 3) { w.x = cvtpk_h(v0[0], v0[1]); w.y = cvtpk_h(v0[2], v0[3]); w.z = cvtpk_h(v1[0], v1[1]); w.w = cvtpk_h(v1[2], v1[3]); }
                    else { w.x = cvtpk(v0[0], v0[1]); w.y = cvtpk(v0[2], v0[3]); w.z = cvtpk(v1[0], v1[1]); w.w = cvtpk(v1[2], v1[3]); }
                    *(u32x4*)(rowp + bj * HALF) = w;
                }
            }
    }
    __device__ __forceinline__ void operator()(const f32x4 (&acc)[2][2][4][2], const Unit& u, int wr, int wc, int fr, int fq) const {
        const int pm = u.pm, pn = u.pn; const bool ctx = pm >= 64;
        const int b = ctx ? pm - 64 : (pm >> 3);
        const int trow0 = (ctx ? 0 : (pm & 7) * 256) + wr * 64 + fr;
        const int kvrow0 = b * TKV + (ctx ? SEQ : 0) + trow0;
        const int latrow0 = pm * 256 + wr * 64 + fr;
        const int seg = pn >> 2, c1 = (pn & 3) * 256 + wc * 32 + 8 * fq;
        switch (seg) {
        case 0: if (ctx) run<0>(acc, AK, 1024, kvrow0, c1, trow0, wc, fq, nullptr); else run<1>(acc, AK, 1024, kvrow0, c1, trow0, wc, fq, nullptr); break;
        case 1: run<0>(acc, AV, 1024, kvrow0, c1, trow0, wc, fq, nullptr); break;
        case 2: run<3>(acc, LFF, 1024, kvrow0, c1, trow0, wc, fq, lbf); break;
        case 3: run<3>(acc, LFB, 1024, kvrow0, c1, trow0, wc, fq, lbb); break;
        case 4: run<0>(acc, RI, 1024, kvrow0, c1, trow0, wc, fq, nullptr); break;
        case 5: run<2>(acc, AQ, 1024, latrow0, c1, trow0, wc, fq, nullptr); break;
        case 6: run<4>(acc, RQ, 1024, latrow0, c1, trow0, wc, fq, nullptr); break;
        case 7: run<4>(acc, RG, 1024, latrow0, c1, trow0, wc, fq, nullptr); break;
        default: run<5>(acc, GATES, 4096, latrow0, (pn - 32) * 256 + wc * 32 + 8 * fq, trow0, wc, fq, nullptr); break;
        }
    }
};
struct EpiMergeA {
    static constexpr bool PERM = true, AFTER_DRAIN = false;
    const u16* GATES; u16* T;
    __device__ __forceinline__ void operator()(const f32x4 (&acc)[2][2][4][2], const Unit& u, int wr, int wc, int fr, int fq) const {
        const int row0 = u.pm * BM + wr * 64 + fr, col0 = u.pn * BM + wc * 32 + 8 * fq;
#pragma unroll
        for (int ai = 0; ai < 2; ++ai)
#pragma unroll
            for (int m = 0; m < 4; ++m) { const size_t r = (size_t)(row0 + ai * HALF + m * 16);
#pragma unroll
                for (int bj = 0; bj < 2; ++bj) { const int c = col0 + bj * HALF;
                    const u32x4 g = *(const u32x4*)(GATES + r * 4096 + c);
                    const f32x4 v0 = acc[ai][bj][m][0], v1 = acc[ai][bj][m][1];
                    u32x4 w; w.x = cvtpk(v0[0] * bflo(g.x), v0[1] * bfhi(g.x)); w.y = cvtpk(v0[2] * bflo(g.y), v0[3] * bfhi(g.y));
                    w.z = cvtpk(v1[0] * bflo(g.z), v1[1] * bfhi(g.z)); w.w = cvtpk(v1[2] * bflo(g.w), v1[3] * bfhi(g.w));
                    *(u32x4*)(T + r * 2048 + c) = w; } }
    }
};
struct EpiMergeB {
    static constexpr bool PERM = true, AFTER_DRAIN = false;
    const u16* GATES; const u16* T; u16* Y;
    __device__ __forceinline__ void operator()(const f32x4 (&acc)[2][2][4][2], const Unit& u, int wr, int wc, int fr, int fq) const {
        const int row0 = u.pm * BM + wr * 64 + fr, col0 = u.pn * BM + wc * 32 + 8 * fq;
#pragma unroll
        for (int ai = 0; ai < 2; ++ai)
#pragma unroll
            for (int m = 0; m < 4; ++m) { const size_t r = (size_t)(row0 + ai * HALF + m * 16);
#pragma unroll
                for (int bj = 0; bj < 2; ++bj) { const int c = col0 + bj * HALF;
                    const u32x4 g = *(const u32x4*)(GATES + r * 4096 + 2048 + c);
                    const u32x4 t = *(const u32x4*)(T + r * 2048 + c);
                    const f32x4 v0 = acc[ai][bj][m][0], v1 = acc[ai][bj][m][1];
                    u32x4 w; w.x = cvtpk(bflo(t.x) + v0[0] * bflo(g.x), bfhi(t.x) + v0[1] * bfhi(g.x)); w.y = cvtpk(bflo(t.y) + v0[2] * bflo(g.y), bfhi(t.y) + v0[3] * bfhi(g.y));
                    w.z = cvtpk(bflo(t.z) + v1[0] * bflo(g.z), bfhi(t.z) + v1[1] * bfhi(g.z)); w.w = cvtpk(bflo(t.w) + v1[2] * bflo(g.w), bfhi(t.w) + v1[3] * bfhi(g.w));
                    *(u32x4*)(Y + r * 2048 + c) = w; } }
    }
};
struct EpiRes {
    static constexpr bool PERM = false, AFTER_DRAIN = false;
    const float* base; float* out; const float* gate;
    __device__ __forceinline__ void operator()(const f32x4 (&acc)[2][2][4][2], const Unit& u, int wr, int wc, int fr, int fq) const {
        const int row0 = u.pm * BM + wr * 64 + fr, col0 = u.pn * BM + wc * 32 + 4 * fq;
        const float* gb = gate + (size_t)(u.pm >> 3) * NIN;
        f32x4 gv[2][2];
#pragma unroll
        for (int bj = 0; bj < 2; ++bj)
#pragma unroll
            for (int n = 0; n < 2; ++n) gv[bj][n] = *(const f32x4*)(gb + col0 + bj * HALF + n * 16);
#pragma unroll
        for (int ai = 0; ai < 2; ++ai)
#pragma unroll
            for (int m = 0; m < 4; ++m) { const size_t off = (size_t)(row0 + ai * HALF + m * 16) * 2048 + col0;
#pragma unroll
                for (int bj = 0; bj < 2; ++bj)
#pragma unroll
                    for (int n = 0; n < 2; ++n) { const f32x4 bs = *(const f32x4*)(base + off + bj * HALF + n * 16);
                        *(f32x4*)(out + off + bj * HALF + n * 16) = bs + gv[bj][n] * acc[ai][bj][m][n]; } }
    }
};
struct EpiUp {
    static constexpr bool PERM = true, AFTER_DRAIN = false;
    u16* U; u16* SIDE;
    __device__ __forceinline__ void operator()(const f32x4 (&acc)[2][2][4][2], const Unit& u, int wr, int wc, int fr, int fq) const {
        const int row0 = u.pm * BM + wr * 64 + fr, col0 = u.pn * BM + wc * 32 + 8 * fq;
#pragma unroll
        for (int ai = 0; ai < 2; ++ai)
#pragma unroll
            for (int m = 0; m < 4; ++m) { const int r = row0 + ai * HALF + m * 16;
                const bool first = ((m & 1) == 0) && fr == 0, last = ((m & 1) == 1) && fr == 15;
#pragma unroll
                for (int bj = 0; bj < 2; ++bj) { const int c = col0 + bj * HALF;
                    const f32x4 v0 = acc[ai][bj][m][0], v1 = acc[ai][bj][m][1];
                    u32x4 w; w.x = cvtpk(v0[0], v0[1]); w.y = cvtpk(v0[2], v0[3]); w.z = cvtpk(v1[0], v1[1]); w.w = cvtpk(v1[2], v1[3]);
                    *(u32x4*)(U + (size_t)r * FF2 + c) = w;
                    if (first) *(u32x4*)(SIDE + ((size_t)(r >> 5) * 2 + 0) * FF2 + c) = w;
                    if (last)  *(u32x4*)(SIDE + ((size_t)(r >> 5) * 2 + 1) * FF2 + c) = w; } }
    }
};
struct EpiNone {
    static constexpr bool PERM = true, AFTER_DRAIN = false; float* sink;
    __device__ __forceinline__ void operator()(const f32x4 (&acc)[2][2][4][2], const Unit& u, int wr, int wc, int fr, int fq) const {
        f32x4 s = acc[0][0][0][0];
#pragma unroll
        for (int ai = 0; ai < 2; ++ai)
#pragma unroll
            for (int bj = 0; bj < 2; ++bj)
#pragma unroll
                for (int m = 0; m < 4; ++m)
#pragma unroll
                    for (int n = 0; n < 2; ++n) s += acc[ai][bj][m][n];
        if (s[0] + s[1] + s[2] + s[3] == 1.2345e30f) sink[0] = s[0];
    }
};
struct OneUnit {
    Unit u;
    __device__ bool next(int i, Unit& o) const { if (i != 0) return false; o = u; return true; }
    __device__ __forceinline__ void a_ready(const Unit&) const {}
    __device__ __forceinline__ void done(const Unit&) const {}
};
struct EpiConv {
    static constexpr bool PERM = true, AFTER_DRAIN = true;
    u16* Gt; u16* SIDE2; const float* cw; const float* cbv;
    __device__ __forceinline__ void fused(f32x4 (&acc)[2][2][4][2], const Unit& u, int wr, int wc, int fr, int fq, PG8_LAS unsigned char* lds, int wid, int lane) const {
#pragma unroll
        for (int ai = 0; ai < 2; ++ai)
#pragma unroll
            for (int m = 0; m < 4; ++m) { const int row = ai * HALF + wr * 64 + m * 16 + fr;
#pragma unroll
                for (int bj = 0; bj < 2; ++bj) { const int chunk = 16 * bj + 4 * wc + fq;
                    const f32x4 v0 = acc[ai][bj][m][0], v1 = acc[ai][bj][m][1];
                    u32x4 w; w.x = cvtpk(v0[0], v0[1]); w.y = cvtpk(v0[2], v0[3]); w.z = cvtpk(v1[0], v1[1]); w.w = cvtpk(v1[2], v1[3]);
                    *(PG8_LAS u32x4*)(lds + row * 512 + ((chunk ^ (row & 31)) << 4)) = w; } }
        __syncthreads();
        const int t = wid * 64 + lane, c8 = t & 15, rg = t >> 4, f = u.pn * 128 + c8 * 8;
        float wa[3][8], wb[3][8], ba[8], bb[8];
#pragma unroll
        for (int j = 0; j < 3; ++j)
#pragma unroll
            for (int i = 0; i < 8; ++i) { wa[j][i] = cw[j * FF2 + f + i]; wb[j][i] = cw[j * FF2 + FF + f + i]; }
#pragma unroll
        for (int i = 0; i < 8; ++i) { ba[i] = cbv[f + i]; bb[i] = cbv[FF + f + i]; }
        float pa[8], pb[8], ca[8], cb[8], na[8], nb[8];
#define CONV_LD(DA, DB, q_) do { const int q__ = (q_); if (q__ >= 0 && q__ < 256) { \
            const u32x4 xa_ = *(const PG8_LAS u32x4*)(lds + q__ * 512 + ((c8 ^ (q__ & 31)) << 4)), xb_ = *(const PG8_LAS u32x4*)(lds + q__ * 512 + (((16 + c8) ^ (q__ & 31)) << 4)); \
            _Pragma("unroll") for (int i_ = 0; i_ < 4; ++i_) { DA[2 * i_] = bflo(xa_[i_]); DA[2 * i_ + 1] = bfhi(xa_[i_]); DB[2 * i_] = bflo(xb_[i_]); DB[2 * i_ + 1] = bfhi(xb_[i_]); } } \
          else { _Pragma("unroll") for (int i_ = 0; i_ < 8; ++i_) { DA[i_] = 0.f; DB[i_] = 0.f; } } } while (0)
        CONV_LD(pa, pb, rg * 8 - 1); CONV_LD(ca, cb, rg * 8);
#pragma unroll
        for (int i8 = 0; i8 < 8; ++i8) { const int r = rg * 8 + i8;
            CONV_LD(na, nb, r + 1);
            u32x4 o;
#pragma unroll
            for (int i = 0; i < 4; ++i) {
                const float a0 = ba[2 * i] + wa[0][2 * i] * pa[2 * i] + wa[1][2 * i] * ca[2 * i] + wa[2][2 * i] * na[2 * i];
                const float a1 = ba[2 * i + 1] + wa[0][2 * i + 1] * pa[2 * i + 1] + wa[1][2 * i + 1] * ca[2 * i + 1] + wa[2][2 * i + 1] * na[2 * i + 1];
                const float b0 = bb[2 * i] + wb[0][2 * i] * pb[2 * i] + wb[1][2 * i] * cb[2 * i] + wb[2][2 * i] * nb[2 * i];
                const float b1 = bb[2 * i + 1] + wb[0][2 * i + 1] * pb[2 * i + 1] + wb[1][2 * i + 1] * cb[2 * i + 1] + wb[2][2 * i + 1] * nb[2 * i + 1];
                o[i] = cvtpk(silu_(a0) * b0, silu_(a1) * b1); }
            *(u32x4*)(Gt + (size_t)(u.pm * BM + r) * FF + f) = o;
#pragma unroll
            for (int i = 0; i < 8; ++i) { pa[i] = ca[i]; pb[i] = cb[i]; ca[i] = na[i]; cb[i] = nb[i]; } }
#undef CONV_LD
        if (t < 128) { const int rr = t >> 5, ch = t & 31, row = (rr < 2) ? rr : 252 + rr;
            const u32x4 v = *(const PG8_LAS u32x4*)(lds + row * 512 + ((ch ^ (row & 31)) << 4));
            *(u32x4*)(SIDE2 + ((size_t)(u.pm * 44 + u.pn) * 4 + rr) * 256 + ch * 8) = v; }
        __syncthreads();
    }
};
}

#define KSWZ(row, colB) ((row) * 256 + ((colB) ^ (((row) & 7) << 4)))
#define SBAR() __builtin_amdgcn_sched_barrier(0)
#define MFMA32(a, b, c) __builtin_amdgcn_mfma_f32_32x32x16_bf16((a), (b), (c), 0, 0, 0)
DI int crow(int r, int hi) { return (r & 3) + 8 * (r >> 2) + 4 * hi; }
DI int v_st(int k, int c) { const int kk = (k & ~0xC) | ((k & 4) << 1) | ((k & 8) >> 1); return ((kk >> 3) * 4 + (c >> 5)) * 512 + ((kk & 7) * 32 + (c & 31)) * 2; }
DI int v_rd_base(int lane) { return ((lane & 3) << 3) | (((lane >> 2) & 3) << 6) | (((lane >> 4) & 1) << 5) | (((lane >> 5) & 1) << 8); }
constexpr int v_rd_off(int d0, int ks, int half) { return d0 * 512 + ks * 4096 + half * 2048; }
typedef short v4i16_t __attribute__((ext_vector_type(4)));
typedef LAS const char* lds_cptr;
DI s16x4 vtr(lds_cptr p) { return __builtin_bit_cast(s16x4, __builtin_amdgcn_ds_read_tr16_b64_v4i16((LAS v4i16_t*)p)); }
#define PKF(L, H) (s16x8){L[0], L[1], L[2], L[3], H[0], H[1], H[2], H[3]}
DI void pv_blk(f32x16& od, int vb, s16x8 pa0, s16x8 pa1, s16x8 pa2, s16x8 pa3) {
  const lds_cptr p = (lds_cptr)(uintptr_t)(unsigned)vb;
  const s16x4 l0 = vtr(p + v_rd_off(0, 0, 0)), h0 = vtr(p + v_rd_off(0, 0, 1)), l1 = vtr(p + v_rd_off(0, 1, 0)), h1 = vtr(p + v_rd_off(0, 1, 1));
  const s16x4 l2 = vtr(p + v_rd_off(0, 2, 0)), h2 = vtr(p + v_rd_off(0, 2, 1)), l3 = vtr(p + v_rd_off(0, 3, 0)), h3 = vtr(p + v_rd_off(0, 3, 1));
  od = MFMA32(pa0, PKF(l0, h0), od); od = MFMA32(pa1, PKF(l1, h1), od); od = MFMA32(pa2, PKF(l2, h2), od); od = MFMA32(pa3, PKF(l3, h3), od);
}
DI void tt_blk(f32x16& od, int ab, int vb) {
  const lds_cptr pa = (lds_cptr)(uintptr_t)(unsigned)ab, p = (lds_cptr)(uintptr_t)(unsigned)vb;
#pragma unroll
  for (int ks = 0; ks < 4; ++ks) {
    const s16x4 a0 = vtr(pa + v_rd_off(0, ks, 0)), a1 = vtr(pa + v_rd_off(0, ks, 1)), l0 = vtr(p + v_rd_off(0, ks, 0)), h0 = vtr(p + v_rd_off(0, ks, 1));
    od = MFMA32(PKF(a0, a1), PKF(l0, h0), od); }
}
#define PK4(P, BASE, OUT) do { unsigned a0_ = cvtpk(P[BASE + 0], P[BASE + 1]), a1_ = cvtpk(P[BASE + 2], P[BASE + 3]);   \
    unsigned b0_ = cvtpk(P[BASE + 4], P[BASE + 5]), b1_ = cvtpk(P[BASE + 6], P[BASE + 7]);                              \
    auto r0_ = __builtin_amdgcn_permlane32_swap(a0_, b0_, false, false); auto r1_ = __builtin_amdgcn_permlane32_swap(a1_, b1_, false, false); \
    u32x4v w_ = {r0_[0], r1_[0], r0_[1], r1_[1]}; OUT = __builtin_bit_cast(s16x8, w_); } while (0)

constexpr float ATT_THR = 8.f;
DI void partialSM(f32x16& p0, f32x16& p1, float& m_reg, f32x16& negm, float& alpha) {
  float pmax = fmaxf(p0[0], p0[1]);
#pragma unroll
  for (int r = 2; r < 16; ++r) pmax = fmaxf(pmax, p0[r]);
#pragma unroll
  for (int r = 0; r < 16; ++r) pmax = fmaxf(pmax, p1[r]);
  { auto rr = __builtin_amdgcn_permlane32_swap(__float_as_uint(pmax), __float_as_uint(pmax), false, false);
    pmax = fmaxf(__uint_as_float(rr[0]), __uint_as_float(rr[1])); }
  alpha = 1.f;
  if (__builtin_expect(!__all(pmax <= ATT_THR), 0)) {
    const float dl = fmaxf(pmax, 0.f); m_reg += dl; alpha = __builtin_amdgcn_exp2f(-dl);
#pragma unroll
    for (int r = 0; r < 16; ++r) { p0[r] -= dl; p1[r] -= dl; negm[r] = -m_reg; }
  }
#pragma unroll
  for (int r = 0; r < 16; ++r) p0[r] = __builtin_amdgcn_exp2f(p0[r]);
}
DI void finishSM(f32x16& p0, f32x16& p1, float alpha, float& l_reg, s16x8& pa0, s16x8& pa1, s16x8& pa2, s16x8& pa3) {
#pragma unroll
  for (int r = 0; r < 16; ++r) p1[r] = __builtin_amdgcn_exp2f(p1[r]);
  float ps = 0;
#pragma unroll
  for (int r = 0; r < 16; ++r) ps += p0[r];
#pragma unroll
  for (int r = 0; r < 16; ++r) ps += p1[r];
  { auto rr = __builtin_amdgcn_permlane32_swap(__float_as_uint(ps), __float_as_uint(ps), false, false);
    ps = __uint_as_float(rr[0]) + __uint_as_float(rr[1]); }
  l_reg = l_reg * alpha + ps;
  PK4(p0, 0, pa0); PK4(p0, 8, pa1); PK4(p1, 0, pa2); PK4(p1, 8, pa3);
}
DI void qkt64(f32x16& p0, f32x16& p1, const char* Ks, const s16x8* qr, const f32x16& negm, int comp, int r32, int hi) {
#pragma unroll
  for (int d0 = 0; d0 < 4; ++d0) { const int cb = (comp * 64 + d0 * 16 + hi * 8) * 2;
    const s16x8 b0 = *(const s16x8*)(Ks + KSWZ(r32, cb));
    const s16x8 b1 = *(const s16x8*)(Ks + KSWZ(32 + r32, cb));
    if (d0 == 0) { p0 = MFMA32(b0, qr[0], negm); p1 = MFMA32(b1, qr[0], negm); }
    else { p0 = MFMA32(b0, qr[d0], p0); p1 = MFMA32(b1, qr[d0], p1); } }
}
constexpr int SHM_V = 16384, SHM_K = 16384, ATT_KOFF = 3 * SHM_V, ATT_WS = 3 * SHM_V + 2 * SHM_K  , ATT_X = 0  , ATT_CTR = 135168  ;
DI void pv_all(f32x16* o, int vb, s16x8 pa0, s16x8 pa1, s16x8 pa2, s16x8 pa3) {
  const lds_cptr p = (lds_cptr)(uintptr_t)(unsigned)vb;
  const s16x8 pa[4] = {pa0, pa1, pa2, pa3};
#pragma unroll
  for (int ks = 0; ks < 4; ++ks)
#pragma unroll
    for (int d0 = 0; d0 < 4; ++d0) { const s16x4 l = vtr(p + v_rd_off(d0, ks, 0)), h = vtr(p + v_rd_off(d0, ks, 1)); o[d0] = MFMA32(pa[ks], PKF(l, h), o[d0]); }
}
template <int AV_> DI void attn_unit(const u16* __restrict__ Qb, u16* __restrict__ Ob, const u16* __restrict__ Kh, const u16* __restrict__ Vh, float lam, const float* __restrict__ subw, char* lds) {
  constexpr int LDK = 1024;
  int tid_ = threadIdx.x; asm volatile("" : "+v"(tid_)); const int tid = tid_, wid = __builtin_amdgcn_readfirstlane(tid >> 6), lane = tid & 63, r32 = lane & 31, hi = lane >> 5;
  const int rb = wid >> 1, comp = wid & 1;
  char* V_lds = lds; char* K_lds = lds + ATT_KOFF;
  float* ws = (float*)(lds + ATT_WS) + wid * 64; float* li_l = ws; float* al_l = ws + 32;
  float m_reg = 0.f, l_reg = 0; f32x16 o[4] = {}; s16x8 qr[4]; f32x16 negm = {};
  const u16* Qw = Qb + (size_t)(rb * 32 + r32) * LDK + comp * 64 + hi * 8;
#pragma unroll
  for (int d0 = 0; d0 < 4; ++d0) qr[d0] = *(const s16x8*)(Qw + d0 * 16);
  const int vb0 = (int)(uintptr_t)V_lds + v_rd_base(lane);
  const char* ksrc[2]; const char* vsrc[2];
#pragma unroll
  for (int i = 0; i < 2; ++i) { const int q = wid + 8 * i;
    { const int row = 4 * q + (lane >> 4), colB = ((lane & 15) * 16) ^ ((row & 7) << 4); ksrc[i] = (const char*)(Kh + (size_t)row * LDK) + colB; }
    { const int st = 2 * q + (lane >> 5), kkx = (st >> 2) * 8 + ((lane & 31) >> 2), c = (st & 3) * 32 + (lane & 3) * 8;
      const int key = (kkx & ~0xC) | ((kkx & 4) << 1) | ((kkx & 8) >> 1); vsrc[i] = (const char*)(Vh + (size_t)key * LDK + c); } }
  const LAS unsigned char* ldsb = (const LAS unsigned char*)lds;
#define SDMA(k0, kb_, vb_) do { const size_t go_ = (size_t)(k0) * LDK * 2; _Pragma("unroll") for (int i_ = 0; i_ < 2; ++i_) { \
    __builtin_amdgcn_global_load_lds((const unsigned*)(ksrc[i_] + go_), (LAS unsigned*)(ldsb + ATT_KOFF + (kb_) * SHM_K + (wid + 8 * i_) * 1024), 16, 0, 0); \
    __builtin_amdgcn_global_load_lds((const unsigned*)(vsrc[i_] + go_), (LAS unsigned*)(ldsb + (vb_) * SHM_V + (wid + 8 * i_) * 1024), 16, 0, 0); } } while (0)
#define SLAND() asm volatile("s_waitcnt vmcnt(0)" ::: "memory")
#define RESCALE(al_) do { if (__any((al_) < 1.f)) { if (hi == 0) al_l[r32] = (al_); LDS_WAIT(); \
    _Pragma("unroll") for (int d = 0; d < 4; ++d) _Pragma("unroll") for (int r = 0; r < 16; ++r) o[d][r] *= al_l[crow(r, hi)]; } } while (0)
  constexpr int NT = TKV / 64;
  f32x16 pA0, pA1, pB0, pB1; float alA, alB; s16x8 pa0, pa1, pa2, pa3;
  SDMA(0, 0, 0); SLAND(); __syncthreads();
  SDMA(64, 1, 1);
  qkt64(pA0, pA1, K_lds, qr, negm, comp, r32, hi); partialSM(pA0, pA1, m_reg, negm, alA);
  SLAND(); __syncthreads();
  int vprev = 0, vnext = 2;
#define VROT() do { vprev = (vprev == 2) ? 0 : vprev + 1; vnext = (vnext == 2) ? 0 : vnext + 1; } while (0)
  for (int j = 1; j + 1 < NT; j += 2) {
    SDMA((j + 1) * 64, 0, vnext);
    qkt64(pB0, pB1, K_lds + SHM_K, qr, negm, comp, r32, hi);
    finishSM(pA0, pA1, alA, l_reg, pa0, pa1, pa2, pa3);
    pv_all(o, vb0 + vprev * SHM_V, pa0, pa1, pa2, pa3);
    partialSM(pB0, pB1, m_reg, negm, alB);
    RESCALE(alB);
    SLAND(); VROT(); __syncthreads();
    if (j + 2 < NT) SDMA((j + 2) * 64, 1, vnext);
    qkt64(pA0, pA1, K_lds, qr, negm, comp, r32, hi);
    finishSM(pB0, pB1, alB, l_reg, pa0, pa1, pa2, pa3);
    pv_all(o, vb0 + vprev * SHM_V, pa0, pa1, pa2, pa3);
    partialSM(pA0, pA1, m_reg, negm, alA);
    RESCALE(alA);
    SLAND(); VROT(); __syncthreads();
  }
  qkt64(pB0, pB1, K_lds + SHM_K, qr, negm, comp, r32, hi);
  finishSM(pA0, pA1, alA, l_reg, pa0, pa1, pa2, pa3);
  pv_all(o, vb0 + vprev * SHM_V, pa0, pa1, pa2, pa3);
  partialSM(pB0, pB1, m_reg, negm, alB);
  RESCALE(alB);
  VROT();
  finishSM(pB0, pB1, alB, l_reg, pa0, pa1, pa2, pa3);
  pv_all(o, vb0 + vprev * SHM_V, pa0, pa1, pa2, pa3);
  __syncthreads();
#undef VROT
  if (hi == 0) li_l[r32] = l_reg; LDS_WAIT();
  float rli[16];
#pragma unroll
  for (int r = 0; r < 16; ++r) rli[r] = __builtin_amdgcn_rcpf(li_l[crow(r, hi)]);
  float* X = (float*)(lds + ATT_X) + rb * 4096;
  if (comp == 1) {
#pragma unroll
    for (int r = 0; r < 16; ++r)
#pragma unroll
      for (int d0 = 0; d0 < 4; ++d0) X[crow(r, hi) * 128 + d0 * 32 + r32] = lam * o[d0][r] * rli[r];
  }
  __syncthreads();
  if (comp == 0) {
    float sw[4];
#pragma unroll
    for (int d0 = 0; d0 < 4; ++d0) sw[d0] = subw[d0 * 32 + r32] * 0.8f;
    u16* Ow = Ob + (size_t)(rb * 32) * LDK;
#pragma unroll
    for (int r = 0; r < 16; ++r) { const int orow = crow(r, hi); float ss = 0.f; float v[4];
#pragma unroll
      for (int d0 = 0; d0 < 4; ++d0) { v[d0] = o[d0][r] * rli[r] - X[orow * 128 + d0 * 32 + r32]; ss += v[d0] * v[d0]; }
#pragma unroll
      for (int of = 1; of < 32; of <<= 1) ss += __shfl_xor(ss, of);
      const float rs = rsqrtf(ss * (1.f / 128.f) + EPS);
#pragma unroll
      for (int d0 = 0; d0 < 4; ++d0) Ow[(size_t)orow * LDK + d0 * 32 + r32] = f2bf(v[d0] * rs * sw[d0]); }
  }
  __syncthreads();
#undef SDMA
#undef SLAND
#undef RESCALE
}

constexpr int SC_QP = 0, SC_KP = 16384, SC_QT = 32768, SC_KH = 49152, SC_VV = 65536, SC_SS = 81920, SC_TOT = 114688, SC_BEND = 118784;
template <int VAR> DI void scan_item(int b, int h, int dir, const u16* __restrict__ KKb, const u16* __restrict__ RI, const u16* __restrict__ RQ, u16* __restrict__ OUT, char* lds) {
  int tid_ = threadIdx.x; asm volatile("" : "+v"(tid_)); const int tid = tid_, wid = __builtin_amdgcn_readfirstlane(tid >> 6), lane = tid & 63, r32 = lane & 31, hi = lane >> 5;
  const int k0 = 2 * lane, seg = wid;
  const int tb = wid >> 2, vb = wid & 3, kb0 = 2 * (wid >> 2);
  const int colh = h * 128;
  float* TOT = (float*)(lds + SC_TOT); float* BEND = (float*)(lds + SC_BEND);
  const int lbase = (int)(uintptr_t)lds;
  const int rdb = v_rd_base(lane);
  f32x16 s0 = {}, s1 = {};
  { u32x4v z = {0u, 0u, 0u, 0u}; *(u32x4v*)(lds + SC_SS + tid * 64) = z; *(u32x4v*)(lds + SC_SS + tid * 64 + 16) = z; *(u32x4v*)(lds + SC_SS + tid * 64 + 32) = z; *(u32x4v*)(lds + SC_SS + tid * 64 + 48) = z; }
  const int sr = tid >> 4, sc = (tid & 15) * 8;
  unsigned gr[8], qv[8]; s16x8 vr0, vr1;
#define SC_LOAD(step_) do { const int st_ = (step_); const bool cx_ = st_ < 4; const int c_ = cx_ ? st_ : st_ - 4; \
    const int ch_ = dir ? (cx_ ? 3 - c_ : 31 - c_) : c_; const unsigned kvb_ = (unsigned)(b * TKV + (cx_ ? SEQ : 0) + ch_ * 64); const unsigned ltb_ = (unsigned)(b * SEQ + ch_ * 64); \
    _Pragma("unroll") for (int j = 0; j < 8; ++j) { const int i_ = 8 * seg + j, tk_ = dir ? 63 - i_ : i_; gr[j] = *(const unsigned*)(KKb + (unsigned)((kvb_ + tk_) * 1024u + colh + k0)); \
      if (!cx_) qv[j] = *(const unsigned*)(RQ + (unsigned)((ltb_ + tk_) * 1024u + colh + k0)); } \
    { const int t0_ = dir ? 63 - sr : sr, t1_ = dir ? 31 - sr : 32 + sr; vr0 = *(const s16x8*)(RI + (unsigned)((kvb_ + t0_) * 1024u + colh + sc)); vr1 = *(const s16x8*)(RI + (unsigned)((kvb_ + t1_) * 1024u + colh + sc)); } } while (0)
  SC_LOAD(0);
  for (int step = 0; step < 36; ++step) {
    const bool isctx = step < 4; const int c = isctx ? step : step - 4;
    const int chunk = dir ? (isctx ? 3 - c : 31 - c) : c;
    const unsigned latbase = (unsigned)(b * SEQ + chunk * 64);
    f32x2 kk[8], q[8], P[8];
#pragma unroll
    for (int j = 0; j < 8; ++j) { kk[j] = (f32x2){1.f - fexp(h2f((u16)(gr[j] & 0xffffu))), 1.f - fexp(h2f((u16)(gr[j] >> 16)))}; q[j] = isctx ? (f32x2){0.f, 0.f} : (f32x2){bflo(qv[j]), bfhi(qv[j])}; }
    { f32x2 a = {1.f, 1.f};
#pragma unroll
      for (int j = 0; j < 8; ++j) { a = a * (1.f - kk[j]); P[j] = a; }
      *(f32x2*)(TOT + seg * 128 + k0) = a; }
    const s16x8 cv0 = vr0, cv1 = vr1;
    __syncthreads();
    if (step + 1 < 36) SC_LOAD(step + 1);
    if (VAR != 2 && VAR != 3) { f32x2 pre = {1.f, 1.f}, suf = {1.f, 1.f}, mid = {1.f, 1.f};
#pragma unroll
      for (int s_ = 0; s_ < 8; ++s_) { const f32x2 t = *(const f32x2*)(TOT + s_ * 128 + k0);
        if (s_ < seg) pre = pre * t;
        if (s_ > seg) suf = suf * t;
        if (seg <= 3 ? (s_ > seg && s_ <= 3) : (s_ >= 4 && s_ < seg)) mid = mid * t; }
      if (seg == 7) *(f32x2*)(BEND + k0) = pre * P[7];
      f32x2 sl = {1.f, 1.f};
#pragma unroll
      for (int j = 7; j >= 0; --j) { const int i = 8 * seg + j;
        const f32x2 khat = kk[j] * (sl * suf);
        *(unsigned*)(lds + SC_KH + v_st(i, k0)) = cvtpk(khat.x, khat.y);
        if (!isctx) {
          const f32x2 qt = q[j] * (pre * P[j]);
          f32x2 e1, e2;
          if (seg <= 3) { e2 = sl * mid; e1.x = __builtin_amdgcn_rcpf(fmaxf(e2.x, 1e-30f)); e1.y = __builtin_amdgcn_rcpf(fmaxf(e2.y, 1e-30f)); }
          else { e1 = mid * P[j]; e2.x = __builtin_amdgcn_rcpf(fmaxf(e1.x, 1e-30f)); e2.y = __builtin_amdgcn_rcpf(fmaxf(e1.y, 1e-30f)); }
          const f32x2 qp = q[j] * e1, kp = kk[j] * e2;
          const int o2 = KSWZ(i, k0 * 2);
          *(unsigned*)(lds + SC_QT + o2) = cvtpk(qt.x, qt.y); *(unsigned*)(lds + SC_QP + o2) = cvtpk(qp.x, qp.y); *(unsigned*)(lds + SC_KP + o2) = cvtpk(kp.x, kp.y); }
        sl = sl * (1.f - kk[j]); }
      *(s16x8*)(lds + SC_VV + v_st(sr, sc)) = cv0; *(s16x8*)(lds + SC_VV + v_st(32 + sr, sc)) = cv1; }
    __syncthreads();
    if (VAR != 1 && VAR != 3) {
    if (!isctx) {
      f32x16 p0 = {}, p1 = {};
      const int trow = tb * 32 + r32;
#pragma unroll
      for (int ks = 0; ks < 8; ++ks) { const int cb = (ks * 16 + hi * 8) * 2;
        const s16x8 qf = *(const s16x8*)(lds + SC_QP + KSWZ(trow, cb));
        const s16x8 kf0 = *(const s16x8*)(lds + SC_KP + KSWZ(r32, cb));
        p0 = MFMA32(kf0, qf, p0);
        if (tb == 1) { const s16x8 kf1 = *(const s16x8*)(lds + SC_KP + KSWZ(32 + r32, cb)); p1 = MFMA32(kf1, qf, p1); } }
      { int dd = r32 - 4 * hi; asm volatile("" : "+v"(dd));
        if (tb == 0) {
#pragma unroll
          for (int r = 0; r < 16; ++r) { if ((r & 3) + 8 * (r >> 2) > dd) p0[r] = 0.f; p1[r] = 0.f; }
        } else {
#pragma unroll
          for (int r = 0; r < 16; ++r) { if ((r & 3) + 8 * (r >> 2) > dd) p1[r] = 0.f; }
        } }
      s16x8 pa0, pa1, pa2, pa3;
      PK4(p0, 0, pa0); PK4(p0, 8, pa1); PK4(p1, 0, pa2); PK4(p1, 8, pa3);
      f32x16 o = {};
      pv_blk(o, lbase + SC_VV + rdb + vb * 512, pa0, pa1, pa2, pa3);
#pragma unroll
      for (int ks = 0; ks < 8; ++ks) { const int cb = (ks * 16 + hi * 8) * 2;
        const s16x8 qa = *(const s16x8*)(lds + SC_QT + KSWZ(trow, cb));
        const s16x8 sb = *(const s16x8*)(lds + SC_SS + KSWZ(vb * 32 + r32, cb));
        o = MFMA32(qa, sb, o); }
#pragma unroll
      for (int r = 0; r < 16; ++r) { const int t = tb * 32 + crow(r, hi), tk = dir ? 63 - t : t;
        OUT[(unsigned)((VAR ? ((latbase + tk) & 1023u) : (latbase + tk)) * 1024u + colh + vb * 32 + r32)] = f2bf(o[r]); }
    }
#pragma unroll
    for (int g = 0; g < 4; ++g) { const f32x4v d0 = *(const f32x4v*)(BEND + kb0 * 32 + 8 * g + 4 * hi), d1 = *(const f32x4v*)(BEND + kb0 * 32 + 32 + 8 * g + 4 * hi);
#pragma unroll
      for (int i = 0; i < 4; ++i) { s0[4 * g + i] *= d0[i]; s1[4 * g + i] *= d1[i]; } }
    tt_blk(s0, lbase + SC_KH + rdb + kb0 * 512, lbase + SC_VV + rdb + vb * 512);
    tt_blk(s1, lbase + SC_KH + rdb + (kb0 + 1) * 512, lbase + SC_VV + rdb + vb * 512);
    }
    __syncthreads();
#pragma unroll
    for (int g = 0; g < 4; ++g) { const int vrow = vb * 32 + r32, kc0 = (kb0 * 32 + 8 * g + 4 * hi) * 2, kc1 = kc0 + 64;
      u32x2v w0 = {cvtpk(s0[4 * g], s0[4 * g + 1]), cvtpk(s0[4 * g + 2], s0[4 * g + 3])}, w1 = {cvtpk(s1[4 * g], s1[4 * g + 1]), cvtpk(s1[4 * g + 2], s1[4 * g + 3])};
      *(u32x2v*)(lds + SC_SS + KSWZ(vrow, kc0)) = w0; *(u32x2v*)(lds + SC_SS + KSWZ(vrow, kc1)) = w1; }
  }
  __syncthreads();
#undef SC_LOAD
}
#define XB_TMO      128
#define XB_XCNT(j)  (256  + 64 * (j))
#define XB_XSUB(j)  (1280 + 64 * (j))
#define XB_XGEN(j)  (2304 + 64 * (j))
#define XB_TOP      3328
#define XB_TOPGEN   3392
#define XCD_BAR_WORDS 3456
#define XB_SPIN_CAP (1u << 18)

__device__ __forceinline__ unsigned xb_ld(unsigned* p)              { return __hip_atomic_load(p, __ATOMIC_RELAXED, __HIP_MEMORY_SCOPE_AGENT); }
__device__ __forceinline__ unsigned xb_add(unsigned* p, unsigned v) { return __hip_atomic_fetch_add(p, v, __ATOMIC_RELAXED, __HIP_MEMORY_SCOPE_AGENT); }
__device__ __forceinline__ unsigned xb_xcc_id() { return (unsigned)__builtin_amdgcn_s_getreg((3 << 11) | 20) & 0xFu; }
#define XB_SPIN(cond, bar) do { unsigned _sp = 0; while (cond) { __builtin_amdgcn_s_sleep(1); \
    if ((++_sp & 255u) == 0u) { if (xb_ld(&(bar)[XB_TMO])) break; if (_sp > XB_SPIN_CAP) { atomicAdd(&(bar)[XB_TMO], 1u); break; } } } } while (0)

struct XcdBarrier {
    unsigned* bar; unsigned x;
    volatile LAS unsigned* st;
};

__device__ __forceinline__ XcdBarrier xcd_barrier_post(unsigned* bar, volatile LAS unsigned* st) {
    XcdBarrier b; b.bar = bar; b.x = xb_xcc_id(); b.st = st;
    if (threadIdx.x == 0) (void)xb_add(&bar[XB_XCNT(b.x)], 1u);
    return b;
}
__device__ __forceinline__ void xcd_barrier_complete(unsigned* bar, unsigned x, unsigned& nloc, unsigned& nx) {
    const unsigned G = gridDim.x * gridDim.y * gridDim.z;
    unsigned sum, cnt, mine, sp = 0u;
    for (;;) {
        sum = 0u; cnt = 0u; mine = 0u;
#pragma unroll
        for (unsigned j = 0; j < 16; ++j) { const unsigned c = xb_ld(&bar[XB_XCNT(j)]); sum += c; cnt += (c > 0u) ? 1u : 0u; mine = (j == x) ? c : mine; }
        if (sum == G) break;
        __builtin_amdgcn_s_sleep(1);
        if ((++sp & 255u) == 0u) { if (xb_ld(&bar[XB_TMO])) break; if (sp > XB_SPIN_CAP) { atomicAdd(&bar[XB_TMO], 1u); break; } }
    }
    nloc = mine > 0u ? mine : 1u; nx = cnt > 0u ? cnt : 1u;
}

__device__ __forceinline__ void xcd_barrier(const XcdBarrier& b) {
    asm volatile("s_waitcnt vmcnt(0)" ::: "memory");
    __syncthreads();
    if (threadIdx.x == 0) {
        unsigned* bar = b.bar;
        __builtin_amdgcn_s_waitcnt(0);
        unsigned nloc = b.st[0], nx = b.st[1];
        if (nloc == 0u) { xcd_barrier_complete(bar, b.x, nloc, nx); b.st[0] = nloc; b.st[1] = nx; }
        const unsigned old = xb_add(&bar[XB_XSUB(b.x)], 1u);
        const unsigned gen = old / nloc;
        if (old + 1u == (gen + 1u) * nloc) {
            __builtin_amdgcn_fence(__ATOMIC_RELEASE, "agent");
            asm volatile("s_waitcnt vmcnt(0)" ::: "memory");
            const unsigned og = xb_add(&bar[XB_TOP], 1u);
            const unsigned tg = og / nx;
            if (og + 1u == (tg + 1u) * nx) xb_add(&bar[XB_TOPGEN], 1u);
            else XB_SPIN(xb_ld(&bar[XB_TOPGEN]) == tg, bar);
            __builtin_amdgcn_fence(__ATOMIC_ACQUIRE, "agent");
            xb_add(&bar[XB_XGEN(b.x)], 1u);
            asm volatile("s_waitcnt vmcnt(0)" ::: "memory");
        } else {
            XB_SPIN(xb_ld(&bar[XB_XGEN(b.x)]) == gen, bar);
            __builtin_amdgcn_fence(__ATOMIC_ACQUIRE, "agent");
            asm volatile("s_waitcnt vmcnt(0)" ::: "memory");
        }
    }
    __syncthreads();
}

#ifndef DUP_MASK
#define DUP_MASK 0
#endif
#ifndef PHASES
#define PHASES 0xfff
#endif
struct Params {
  const float *x, *c, *ctx, *c_ctx, *w_mod, *b_mod, *norm1_w, *w_in, *lam_q1, *lam_k1, *lam_q2, *lam_k2, *subln_w, *rec_lb, *rec_gnorm_w,
              *w_branch_attn, *w_branch_rec, *w_out, *norm2_w, *w_up, *conv_w, *conv_b, *w_down, *final_norm_w;
  float* out; unsigned char* ws;
};
DI int cperm(int p) { return 16 * ((p >> 2) & 1) + 4 * (p >> 3) + (p & 3); }
DI void transpose_item(const float* __restrict__ W, int K, int N, u16* __restrict__ WT, float* scr, int item, int lane, bool perm, bool pair_up = false) {
  const int nblk = N / 32, kb = item / nblk, nb = item % nblk, k0 = 64 * kb, n0 = 32 * nb;
  const int ns0 = pair_up ? (((n0 & 255) < 128) ? 128 * (n0 >> 8) + (n0 & 255) : FF + 128 * (n0 >> 8) + (n0 & 255) - 128) : n0;
  float tv[32];
#pragma unroll
  for (int i = 0; i < 32; ++i) { const int kk = 2 * i + (lane >> 5); tv[i] = W[(size_t)(k0 + kk) * N + ns0 + (lane & 31)]; }
#pragma unroll
  for (int i = 0; i < 32; ++i) { const int kk = 2 * i + (lane >> 5); scr[kk * 33 + (lane & 31)] = tv[i]; }
  LDS_WAIT(); asm volatile("" ::: "memory");
  const int c = lane & 7;
#pragma unroll
  for (int j = 0; j < 4; ++j) { const int n = (lane >> 3) + 8 * j; const float* s = scr + (8 * c) * 33 + (perm ? cperm(n) : n);
    u32x4v o; o.x = cvtpk(s[0 * 33], s[1 * 33]); o.y = cvtpk(s[2 * 33], s[3 * 33]); o.z = cvtpk(s[4 * 33], s[5 * 33]); o.w = cvtpk(s[6 * 33], s[7 * 33]);
    *(u32x4v*)(WT + (size_t)(n0 + n) * K + k0 + 8 * c) = o; }
  LDS_WAIT(); asm volatile("" ::: "memory");
}
DI void mod_item(const Params& p, float* mod, int item, int lane) {
  const int cb = item % 48, kch = item / 48, c0 = cb * 256 + lane * 4, k0 = kch * 64;
  float sv[9];
#pragma unroll
  for (int r = 0; r < 8; ++r) sv[r] = silu_(p.c[r * DM + k0 + lane]);
  sv[8] = silu_(p.c_ctx[k0 + lane]);
  f32x4v acc[9];
#pragma unroll
  for (int r = 0; r < 9; ++r) acc[r] = (f32x4v){0.f, 0.f, 0.f, 0.f};
  if (kch == 0) { const f32x4v bv = *(const f32x4v*)(p.b_mod + c0);
#pragma unroll
    for (int r = 0; r < 9; ++r) acc[r] = bv; }
#pragma unroll 4
  for (int kk = 0; kk < 64; ++kk) { const f32x4v w = *(const f32x4v*)(p.w_mod + (size_t)(k0 + kk) * NIN + c0);
#pragma unroll
    for (int r = 0; r < 9; ++r) { const float s = __shfl(sv[r], kk); acc[r] += w * s; } }
#pragma unroll
  for (int r = 0; r < 9; ++r)
#pragma unroll
    for (int j = 0; j < 4; ++j) unsafeAtomicAdd(mod + (size_t)r * NIN + c0 + j, acc[r][j]);
}
DI void sincos_small(float a, float& sn, float& cs) {
  const double x = (double)a; const double kq = __builtin_rint(x * 0.63661977236758134308);
  const double r = (x - kq * 1.5707963267948966192) ; const double r2 = r * r;
  double s = r * (1.0 + r2 * (-1.0 / 6 + r2 * (1.0 / 120 + r2 * (-1.0 / 5040 + r2 * (1.0 / 362880 + r2 * (-1.0 / 39916800 + r2 * (1.0 / 6227020800.0)))))));
  double c = 1.0 + r2 * (-0.5 + r2 * (1.0 / 24 + r2 * (-1.0 / 720 + r2 * (1.0 / 40320 + r2 * (-1.0 / 3628800 + r2 * (1.0 / 479001600 + r2 * (-1.0 / 87178291200.0)))))));
  const int q = ((int)kq) & 3;
  const double ss = (q == 0) ? s : (q == 1) ? c : (q == 2) ? -s : -c;
  const double cc = (q == 0) ? c : (q == 1) ? -s : (q == 2) ? -c : s;
  sn = (float)ss; cs = (float)cc;
}
DI void norm_mod_row(const float* __restrict__ xrow, const float* __restrict__ nw, const float* __restrict__ sc, const float* __restrict__ sh, u16* __restrict__ orow, int lane) {
  const f32x4v* xr = (const f32x4v*)xrow + lane; f32x4v v[8]; float s = 0.f;
#pragma unroll
  for (int j = 0; j < 8; ++j) { v[j] = xr[64 * j]; s += (v[j].x * v[j].x + v[j].y * v[j].y) + (v[j].z * v[j].z + v[j].w * v[j].w); }
  const float rstd = rsqrtf(wave_sum(s) * (1.f / DM) + EPS);
#pragma unroll
  for (int j = 0; j < 8; ++j) { const int c = 4 * (lane + 64 * j);
    const f32x4v w = *(const f32x4v*)(nw + c), a = *(const f32x4v*)(sc + c), d = *(const f32x4v*)(sh + c);
    const f32x4v y = v[j] * rstd * w * (1.f + a) + d;
    u32x2v o; o.x = cvtpk(y.x, y.y); o.y = cvtpk(y.z, y.w); *(u32x2v*)(orow + c) = o; }
}

DI void rec_readout_row(const u16* __restrict__ OF, const u16* __restrict__ OB, u16* RG, const float* __restrict__ gnw, int m, int lane) {
    const size_t off = (size_t)m * 1024 + lane * 16;
    const u32x4v a0 = *(const u32x4v*)(OF + off), a1 = *(const u32x4v*)(OF + off + 8), b0 = *(const u32x4v*)(OB + off), b1 = *(const u32x4v*)(OB + off + 8);
    const u32x4v g0 = *(const u32x4v*)(RG + off), g1 = *(const u32x4v*)(RG + off + 8);
    float v[16]; float s = 0.f;
#pragma unroll
    for (int i = 0; i < 4; ++i) { v[2 * i] = bflo(a0[i]) + bflo(b0[i]); v[2 * i + 1] = bfhi(a0[i]) + bfhi(b0[i]); v[8 + 2 * i] = bflo(a1[i]) + bflo(b1[i]); v[8 + 2 * i + 1] = bfhi(a1[i]) + bfhi(b1[i]); }
#pragma unroll
    for (int i = 0; i < 16; ++i) s += v[i] * v[i];
    const float rstd = rsqrtf(wave_sum(s) * (1.f / 1024.f) + EPS);
    const float* gw_ = gnw + lane * 16;
    u32x4v o0, o1;
#pragma unroll
    for (int i = 0; i < 4; ++i) {
      o0[i] = cvtpk(v[2 * i] * rstd * gw_[2 * i] * bflo(g0[i]), v[2 * i + 1] * rstd * gw_[2 * i + 1] * bfhi(g0[i]));
      o1[i] = cvtpk(v[8 + 2 * i] * rstd * gw_[8 + 2 * i] * bflo(g1[i]), v[8 + 2 * i + 1] * rstd * gw_[8 + 2 * i + 1] * bfhi(g1[i])); }
    *(u32x4v*)(RG + off) = o0; *(u32x4v*)(RG + off + 8) = o1;
}
typedef const __attribute__((address_space(4))) Params* KargP;
#if defined(__HIP_DEVICE_COMPILE__)
#define LOAD_PARAMS() KargP kp_ = (KargP)__builtin_amdgcn_kernarg_segment_ptr(); asm volatile("" : "+s"(kp_)); const Params p = *kp_;
#else
#define LOAD_PARAMS() const Params p = p_unused;
#endif
#define PHASE_BEGIN() \
  LOAD_PARAMS() \
  int tid_ = threadIdx.x; asm volatile("" : "+v"(tid_)); const int tid = tid_, lane = tid & 63, wave = __builtin_amdgcn_readfirstlane(tid >> 6); \
  const int G = gridDim.x, bx = blockIdx.x, gw = bx * 8 + wave, NGW = G * 8; (void)gw; (void)NGW; (void)lane; \
  unsigned char* ws = p.ws; float* ctl = (float*)(ws + WS_CTL); float* mod = ctl + C_MOD; (void)mod; \
  char* lds = (char*)lds_raw; (void)lds; pg8::LdsPtr glds = (pg8::LdsPtr)lds_raw; (void)glds;
#define WSP(name, off) u16* name = (u16*)(ws + (off))
__global__ void __launch_bounds__(512, 2) fwd_megakernel(Params p_unused) {
  extern __shared__ __attribute__((aligned(16))) unsigned char lds_raw[];
  cg::grid_group grid = cg::this_grid();
  { volatile LAS unsigned* st_ = (volatile LAS unsigned*)((LAS unsigned char*)lds_raw + XB_LDS_OFF);
    if (threadIdx.x < 2) st_[threadIdx.x] = 0u;
    __syncthreads();
    LOAD_PARAMS()
    (void)xcd_barrier_post((unsigned*)(p.ws + WS_CTL) + C_BAR, st_); }
#define FAST_SYNC() do { LOAD_PARAMS() XcdBarrier xb_; xb_.bar = (unsigned*)(p.ws + WS_CTL) + C_BAR; xb_.x = xb_xcc_id(); \
    xb_.st = (volatile LAS unsigned*)((LAS unsigned char*)lds_raw + XB_LDS_OFF); xcd_barrier(xb_); } while (0)
  _Pragma("unroll") for (int rep = 0; rep <= ((DUP_MASK >> 0) & 1); ++rep) {
  if (PHASES & (1 << 0)) {
  PHASE_BEGIN() WSP(WUP, WS_WUP); WSP(WDN, WS_WDN); WSP(WIN, WS_WIN); WSP(WBA, WS_WBA); WSP(WBR, WS_WBR); WSP(WOUT, WS_WOUT);
  {
    float* scr = (float*)(lds + wave * 16384);
    constexpr int I_IN = 32 * 384, I_UP = 32 * 352;
    constexpr int NITEMS = I_IN + I_UP;
    if (rep == 0 && gw < 1536) mod_item(p, mod, gw, lane);
    for (int it = gw; it < NITEMS; it += NGW) {
      int r = it;
      if (r < I_IN) { const int nb = r % 384; transpose_item(p.w_in, DM, NIN, WIN, scr, r, lane, (nb < 32) || (nb >= 160 && nb < 192)); continue; } r -= I_IN;
      transpose_item(p.w_up, DM, FF2, WUP, scr, r, lane, false, true);
    }
    if (bx == G - 1) {
      if (wave == 0) { const float a = wave_sum(p.lam_q1[lane] * p.lam_k1[lane]), bq = wave_sum(p.lam_q2[lane] * p.lam_k2[lane]);
        if (lane == 0) ctl[C_LAM] = __expf(a) - __expf(bq) + 0.2f; }
      for (int k = tid; k < 1024; k += 512) { ctl[C_LBF + k] = sigm(p.rec_lb[k] - p.rec_lb[1024 + k]); ctl[C_LBB + k] = sigm(p.rec_lb[2048 + k] - p.rec_lb[3072 + k]); }
    }
    if (bx == G - 2) {
      for (int e = tid; e < 1024; e += 512) { const int pos = e >> 4, j = e & 15; const float iv = __builtin_amdgcn_exp2f(-(float)j * 0.83048202372184058696f);
        float sn, cs; sincos_small((float)pos * iv, sn, cs); ctl[C_COS + e] = cs; ctl[C_SIN + e] = sn; }
    }
  }
  }
  FAST_SYNC();
  if (gridDim.x == 0x7fffffffu) grid.sync();
  }
  _Pragma("unroll") for (int rep = 0; rep <= ((DUP_MASK >> 1) & 1); ++rep) {
  if (PHASES & (1 << 1)) {
  PHASE_BEGIN() WSP(H, WS_H);
  for (int m = gw; m < MALL; m += NGW) {
    if (m < MTOK) { const float* mr = mod + (size_t)(m >> 11) * NIN; norm_mod_row(p.x + (size_t)m * DM, p.norm1_w, mr + 2048, mr, H + (size_t)m * DM, lane); }
    else { const float* mr = mod + (size_t)8 * NIN; norm_mod_row(p.ctx + (size_t)(m - MTOK) * DM, p.norm1_w, mr + 2048, mr, H + (size_t)m * DM, lane); }
  }
  }
  FAST_SYNC();
  }
  _Pragma("unroll") for (int rep = 0; rep <= ((DUP_MASK >> 2) & 1); ++rep) {
  if (PHASES & (1 << 2)) {
  PHASE_BEGIN() WSP(H, WS_H); WSP(WIN, WS_WIN); WSP(AK, WS_AK); WSP(AV, WS_AV); WSP(LFF, WS_LFF); WSP(LFB, WS_LFB); WSP(RI, WS_RI); WSP(RQ, WS_RQ); WSP(AQ, WS_AQ); WSP(RG, WS_RG); u16* GATES = (u16*)p.out;
  {
    pg8::Gemm g{H, WIN, MALL, NIN, DM, DM}; pg8::OrderIn S; S.init(G, bx);
    pg8::EpiIn E{AK, AV, LFF, LFB, RI, AQ, RQ, RG, GATES, ctl + C_LBF, ctl + C_LBB, ctl + C_COS, ctl + C_SIN};
#ifdef PROBE_EPINONE
    if (rep == 1) { pg8::EpiNone EN{(float*)(ws + WS_CTL) + 200000}; pg8::gemm_phase<pg8::EpiNone, pg8::OrderIn, true, true>(glds, g, S, EN); } else
#endif
    pg8::gemm_phase<pg8::EpiIn, pg8::OrderIn, true, true>(glds, g, S, E);
    const int tf_ = (G > 160) ? 160 : 0;
    if (bx >= tf_) {
      __syncthreads();
      float* scr = (float*)(lds + wave * 16384);
      constexpr int I_BA = 16 * 64, I_OUT = 32 * 64, I_DN = 88 * 64, NIT2 = 2 * I_BA + I_OUT + I_DN;
      WSP(WBA, WS_WBA); WSP(WBR, WS_WBR); WSP(WOUT, WS_WOUT); WSP(WDN, WS_WDN);
      for (int it = (bx - tf_) * 8 + wave; it < NIT2; it += (G - tf_) * 8) {
        int r = it;
        if (r < I_BA) { transpose_item(p.w_branch_attn, 1024, DM, WBA, scr, r, lane, false); continue; } r -= I_BA;
        if (r < I_BA) { transpose_item(p.w_branch_rec, 1024, DM, WBR, scr, r, lane, false); continue; } r -= I_BA;
        if (r < I_OUT) { transpose_item(p.w_out, DM, DM, WOUT, scr, r, lane, false); continue; } r -= I_OUT;
        transpose_item(p.w_down, FF, DM, WDN, scr, r, lane, false);
      }
    }
  }
  }
  FAST_SYNC();
  }
  _Pragma("unroll") for (int rep = 0; rep <= ((DUP_MASK >> 3) & 1); ++rep) {
  if (PHASES & (1 << 3)) {
  PHASE_BEGIN() WSP(AK, WS_AK); WSP(AV, WS_AV); WSP(LFF, WS_LFF); WSP(LFB, WS_LFB); WSP(RI, WS_RI); WSP(RQ, WS_RQ); WSP(AQ, WS_AQ); WSP(ATT, WS_ATT); WSP(OF, WS_OF); WSP(OB, WS_OB); WSP(RG, WS_RG);
  {
#ifndef NO_SCAN
#ifdef PROBE_ATTONLY
    if (rep == 0)
#endif
    if (bx < 128) { const int b = bx >> 4, h = (bx >> 1) & 7, dir = bx & 1;
#ifdef PROBE_SCANVAR
      if (rep == 1) scan_item<PROBE_SCANVAR>(b, h, dir, dir ? LFB : LFF, RI, RQ, (u16*)(ws + 196 * MiB), lds); else
#endif
      scan_item<0>(b, h, dir, dir ? LFB : LFF, RI, RQ, dir ? OB : OF, lds);
      asm volatile("s_waitcnt vmcnt(0)" ::: "memory"); __syncthreads();
      if (tid == 0) { __builtin_amdgcn_fence(__ATOMIC_RELEASE, "agent"); asm volatile("s_waitcnt vmcnt(0)" ::: "memory");
        (void)__hip_atomic_fetch_add((unsigned*)(ctl + C_CTR) + 1024, 1u, __ATOMIC_RELAXED, __HIP_MEMORY_SCOPE_AGENT); } }
#endif
#ifndef NO_ATT
#ifdef PROBE_SCANONLY
    if (rep == 0)
#endif
    {
    const float lam = ctl[C_LAM];
    const unsigned xcc = (unsigned)__builtin_amdgcn_s_getreg((3 << 11) | 20) & 7u;
    for (int qi = 0; qi < 8; ++qi) {
      const unsigned q = (xcc + (unsigned)qi) & 7u;
      unsigned* ctr = (unsigned*)(ctl + C_CTR) + 512 * rep + 32 * q;
      for (;;) {
        if (tid == 0) *(volatile unsigned*)(lds + ATT_CTR) = atomicAdd(ctr, 1u);
        __syncthreads();
        const unsigned u = *(volatile unsigned*)(lds + ATT_CTR);
        __syncthreads();
        if (u >= 128u) break;
        const int b = (int)q, h = (int)(u >> 4), qb = (int)(u & 15u);
#ifdef PROBE_ATTVAR
        if (rep == 1) attn_unit<PROBE_ATTVAR>(AQ + ((size_t)b * SEQ + qb * 128) * 1024 + h * 128, (u16*)(ws + 196 * MiB) + (size_t)(qb & 7) * 128 * 1024 + h * 128, AK + (size_t)b * TKV * 1024 + h * 128, AV + (size_t)b * TKV * 1024 + h * 128, lam, p.subln_w, lds); else
#endif
        attn_unit<0>(AQ + ((size_t)b * SEQ + qb * 128) * 1024 + h * 128, ATT + ((size_t)b * SEQ + qb * 128) * 1024 + h * 128, AK + (size_t)b * TKV * 1024 + h * 128, AV + (size_t)b * TKV * 1024 + h * 128, lam, p.subln_w, lds);
      }
    }
    }
#endif
    { unsigned* sdone = (unsigned*)(ctl + C_CTR) + 1024; unsigned* rq = (unsigned*)(ctl + C_CTR) + 1056;
      if (tid == 0) { unsigned sp = 0u;
        while (__hip_atomic_load(sdone, __ATOMIC_RELAXED, __HIP_MEMORY_SCOPE_AGENT) < 128u) { __builtin_amdgcn_s_sleep(8); if (++sp > (1u << 20)) break; }
        __builtin_amdgcn_fence(__ATOMIC_ACQUIRE, "agent"); asm volatile("s_waitcnt vmcnt(0)" ::: "memory"); }
      __syncthreads();
      for (;;) {
        if (tid == 0) *(volatile unsigned*)(lds + ATT_CTR) = atomicAdd(rq, 1u);
        __syncthreads();
        const unsigned it = *(volatile unsigned*)(lds + ATT_CTR);
        __syncthreads();
        if (it >= 256u) break;
#pragma unroll 1
        for (int i = 0; i < 8; ++i) rec_readout_row(OF, OB, RG, p.rec_gnorm_w, (int)it * 64 + wave * 8 + i, lane);
      } }
  }
  }
  FAST_SYNC();
  }
  _Pragma("unroll") for (int rep = 0; rep <= ((DUP_MASK >> 5) & 1); ++rep) {
  if (PHASES & (1 << 5)) {
  PHASE_BEGIN() WSP(ATT, WS_ATT); WSP(RG, WS_RG); WSP(WBA, WS_WBA); WSP(WBR, WS_WBR); WSP(Y, WS_Y); u16* T = (u16*)(ws + WS_T); u16* GATES = (u16*)p.out;
  {
    pg8::StaticOrder S; S.init(MTOK, DM, G, bx);
    { pg8::Gemm g{ATT, WBA, MTOK, DM, 1024, 1024}; pg8::EpiMergeA E{GATES, T}; pg8::gemm_phase<pg8::EpiMergeA, pg8::StaticOrder, true, true>(glds, g, S, E); }
    __syncthreads();
    { pg8::Gemm g{RG, WBR, MTOK, DM, 1024, 1024}; pg8::EpiMergeB E{GATES, T, Y}; pg8::gemm_phase<pg8::EpiMergeB, pg8::StaticOrder, true, true>(glds, g, S, E); }
  }
  }
  FAST_SYNC();
  }
  _Pragma("unroll") for (int rep = 0; rep <= ((DUP_MASK >> 6) & 1); ++rep) {
  if (PHASES & (1 << 6)) {
  PHASE_BEGIN() WSP(Y, WS_Y); WSP(WOUT, WS_WOUT);
  {
    pg8::StaticOrder S; S.init(MTOK, DM, G, bx);
    pg8::Gemm g{Y, WOUT, MTOK, DM, DM, DM}; pg8::EpiRes E{p.x, p.out, mod + 4096};
    pg8::gemm_phase<pg8::EpiRes, pg8::StaticOrder, true, true>(glds, g, S, E);
  }
  }
  FAST_SYNC();
  }
  _Pragma("unroll") for (int rep = 0; rep <= ((DUP_MASK >> 7) & 1); ++rep) {
  if (PHASES & (1 << 7)) {
  PHASE_BEGIN() WSP(H2, WS_H2);
  for (int m = gw; m < MTOK; m += NGW) { const float* mr = mod + (size_t)(m >> 11) * NIN; norm_mod_row(p.out + (size_t)m * DM, p.norm2_w, mr + 8192, mr + 6144, H2 + (size_t)m * DM, lane); }
  }
  FAST_SYNC();
  }
  _Pragma("unroll") for (int rep = 0; rep <= ((DUP_MASK >> 8) & 1); ++rep) {
  if (PHASES & (1 << 8)) {
  PHASE_BEGIN() WSP(H2, WS_H2); WSP(WUP, WS_WUP); WSP(U, WS_U); WSP(SIDE, WS_SIDE);
  {
    pg8::StaticOrder so; so.init(MTOK, FF2, G, bx);
    pg8::Gemm g{H2, WUP, MTOK, FF2, DM, DM}; pg8::EpiConv E{U, SIDE, p.conv_w, p.conv_b};
    pg8::Unit uu;
    for (int i = 0; so.next(i, uu); ++i) { pg8::OneUnit S1{uu}; pg8::gemm_phase<pg8::EpiConv, pg8::OneUnit, false, true>(glds, g, S1, E); }
  }
  }
  FAST_SYNC();
  }
  _Pragma("unroll") for (int rep = 0; rep <= ((DUP_MASK >> 9) & 1); ++rep) {
  if (PHASES & (1 << 9)) {
  PHASE_BEGIN() WSP(U, WS_U); WSP(SIDE, WS_SIDE);
  for (int it = gw; it < 64 * 2 * 11; it += NGW) {
    const int pg = it % 11, which = (it / 11) & 1, pm = it / 22;
    const int pn = pg * 4 + (lane >> 4), c8 = lane & 15, f = pn * 128 + c8 * 8;
    const bool edge = which == 0 ? ((pm & 7) == 0) : ((pm & 7) == 7);
    float wa[3][8], wb[3][8], ba[8], bb[8];
#pragma unroll
    for (int j = 0; j < 3; ++j)
#pragma unroll
      for (int i = 0; i < 8; ++i) { wa[j][i] = p.conv_w[j * FF2 + f + i]; wb[j][i] = p.conv_w[j * FF2 + FF + f + i]; }
#pragma unroll
    for (int i = 0; i < 8; ++i) { ba[i] = p.conv_b[f + i]; bb[i] = p.conv_b[FF + f + i]; }
    const u32x4v z = {0u, 0u, 0u, 0u};
    const u16* s_own = SIDE + ((size_t)(pm * 44 + pn) * 4) * 256;
    u32x4v pa, pb, ca, cb, na, nb;
    if (which == 0) {
      if (edge) { pa = z; pb = z; } else { const u16* sp = SIDE + ((size_t)((pm - 1) * 44 + pn) * 4 + 3) * 256; pa = *(const u32x4v*)(sp + c8 * 8); pb = *(const u32x4v*)(sp + 128 + c8 * 8); }
      ca = *(const u32x4v*)(s_own + c8 * 8); cb = *(const u32x4v*)(s_own + 128 + c8 * 8);
      na = *(const u32x4v*)(s_own + 256 + c8 * 8); nb = *(const u32x4v*)(s_own + 256 + 128 + c8 * 8);
    } else {
      pa = *(const u32x4v*)(s_own + 512 + c8 * 8); pb = *(const u32x4v*)(s_own + 512 + 128 + c8 * 8);
      ca = *(const u32x4v*)(s_own + 768 + c8 * 8); cb = *(const u32x4v*)(s_own + 768 + 128 + c8 * 8);
      if (edge) { na = z; nb = z; } else { const u16* sp = SIDE + ((size_t)((pm + 1) * 44 + pn) * 4 + 0) * 256; na = *(const u32x4v*)(sp + c8 * 8); nb = *(const u32x4v*)(sp + 128 + c8 * 8); }
    }
    u32x4v o;
#pragma unroll
    for (int i = 0; i < 4; ++i) {
      const float a0 = ba[2 * i] + wa[0][2 * i] * bflo(pa[i]) + wa[1][2 * i] * bflo(ca[i]) + wa[2][2 * i] * bflo(na[i]);
      const float a1 = ba[2 * i + 1] + wa[0][2 * i + 1] * bfhi(pa[i]) + wa[1][2 * i + 1] * bfhi(ca[i]) + wa[2][2 * i + 1] * bfhi(na[i]);
      const float b0 = bb[2 * i] + wb[0][2 * i] * bflo(pb[i]) + wb[1][2 * i] * bflo(cb[i]) + wb[2][2 * i] * bflo(nb[i]);
      const float b1 = bb[2 * i + 1] + wb[0][2 * i + 1] * bfhi(pb[i]) + wb[1][2 * i + 1] * bfhi(cb[i]) + wb[2][2 * i + 1] * bfhi(nb[i]);
      o[i] = cvtpk(silu_(a0) * b0, silu_(a1) * b1); }
    *(u32x4v*)(U + (size_t)(pm * 256 + (which ? 255 : 0)) * FF + f) = o;
  }
  }
  FAST_SYNC();
  }
  _Pragma("unroll") for (int rep = 0; rep <= ((DUP_MASK >> 10) & 1); ++rep) {
  if (PHASES & (1 << 10)) {
  PHASE_BEGIN() WSP(U, WS_U); WSP(WDN, WS_WDN);
  {
    pg8::StaticOrder S; S.init(MTOK, DM, G, bx);
    pg8::Gemm g{U, WDN, MTOK, DM, FF, FF}; pg8::EpiRes E{p.out, p.out, mod + 10240};
    pg8::gemm_phase<pg8::EpiRes, pg8::StaticOrder, true, true>(glds, g, S, E);
  }
  }
  FAST_SYNC();
  }
  _Pragma("unroll") for (int rep = 0; rep <= ((DUP_MASK >> 11) & 1); ++rep) {
  if (PHASES & (1 << 11)) {
  PHASE_BEGIN()
  for (int m = gw; m < MTOK; m += NGW) {
    f32x4v* xr = (f32x4v*)(p.out + (size_t)m * DM) + lane; f32x4v v[8]; float s = 0.f;
#pragma unroll
    for (int j = 0; j < 8; ++j) { v[j] = xr[64 * j]; s += (v[j].x * v[j].x + v[j].y * v[j].y) + (v[j].z * v[j].z + v[j].w * v[j].w); }
    const float rstd = rsqrtf(wave_sum(s) * (1.f / DM) + EPS);
#pragma unroll
    for (int j = 0; j < 8; ++j) { const f32x4v w = *(const f32x4v*)(p.final_norm_w + 4 * (lane + 64 * j)); xr[64 * j] = v[j] * rstd * w; }
  }
  }
  }
}

extern "C" void kernel_launch(void* const* d_in, const int* in_sizes, int n_in, void* d_out, int out_size, void* d_ws, size_t ws_size, hipStream_t stream) {
  static int grid = 0;
  if (grid == 0) {
    if (n_in != 24 || in_sizes[0] != MTOK * DM || out_size != MTOK * DM || ws_size < WS_END) {
      fprintf(stderr, "kernel_launch: unexpected shapes: n_in %d in0 %d out %d ws %zu (need >= %zu)\n", n_in, n_in > 0 ? in_sizes[0] : -1, out_size, ws_size, (size_t)WS_END); grid = -1; return; }
    int dev = 0, cus = 0, per_cu = 0;
    if (hipGetDevice(&dev) != hipSuccess || hipDeviceGetAttribute(&cus, hipDeviceAttributeMultiprocessorCount, dev) != hipSuccess) { grid = -1; return; }
    if (hipFuncSetAttribute((const void*)fwd_megakernel, hipFuncAttributeMaxDynamicSharedMemorySize, LDS_BYTES) != hipSuccess) { fprintf(stderr, "kernel_launch: hipFuncSetAttribute failed\n"); grid = -1; return; }
    if (hipOccupancyMaxActiveBlocksPerMultiprocessor(&per_cu, (const void*)fwd_megakernel, 512, LDS_BYTES) != hipSuccess || per_cu < 1) { fprintf(stderr, "kernel_launch: occupancy query says %d\n", per_cu); }
    (void)hipGetLastError();
    grid = cus;
    if (grid != 256) fprintf(stderr, "kernel_launch: note: %d CUs\n", grid);
  }
  if (grid < 0) return;
  (void)hipMemsetAsync((char*)d_ws + WS_CTL, 0, CTL_ZERO_BYTES, stream);
  Params p{};
  const float** pp = (const float**)&p;
  for (int i = 0; i < 24; ++i) pp[i] = (const float*)d_in[i];
  p.out = (float*)d_out; p.ws = (unsigned char*)d_ws;
  void* args[] = {&p};
  hipError_t e = hipLaunchCooperativeKernel((const void*)fwd_megakernel, dim3(grid), dim3(512), args, LDS_BYTES, stream);
  if (e != hipSuccess) fprintf(stderr, "kernel_launch: cooperative launch failed: %s (grid %d)\n", hipGetErrorString(e), grid);
}
```

```cpp
#include <hip/hip_runtime.h>
#include <hip/hip_cooperative_groups.h>
#include <cstdio>
#include <cstdint>
namespace cg = cooperative_groups;
#define DI __device__ __forceinline__
#define LAS __attribute__((address_space(3)))
typedef unsigned short u16;
typedef float f32x2 __attribute__((ext_vector_type(2)));
typedef float f32x4v __attribute__((ext_vector_type(4)));
typedef float f32x16 __attribute__((ext_vector_type(16)));
typedef short s16x8 __attribute__((ext_vector_type(8)));
typedef short s16x4 __attribute__((ext_vector_type(4)));
typedef unsigned u32x4v __attribute__((ext_vector_type(4)));
typedef unsigned u32x2v __attribute__((ext_vector_type(2)));
typedef __bf16 bf16x2_t __attribute__((ext_vector_type(2)));
typedef _Float16 h16x2_t __attribute__((ext_vector_type(2)));

constexpr int DM = 2048, NB = 8, SEQ = 2048, MTOK = NB * SEQ, CTXL = 256, MCTX = NB * CTXL, MALL = MTOK + MCTX;
constexpr int NIN = 12288, TKV = SEQ + CTXL  , FF = 5632, FF2 = 2 * FF;
constexpr float EPS = 1e-6f;
constexpr size_t MiB = 1u << 20;
constexpr size_t WS_CTL = 0, WS_WUP = 2 * MiB, WS_WDN = 46 * MiB, WS_SIDE = 68 * MiB, WS_H2 = 91 * MiB, WS_U = 155 * MiB, WS_END = 507 * MiB;
constexpr size_t WS_WIN = 68 * MiB, WS_WBA = 116 * MiB, WS_WBR = 120 * MiB, WS_WOUT = 124 * MiB, WS_H = 132 * MiB, WS_OF = 132 * MiB, WS_OB = 164 * MiB;
constexpr size_t WS_AK = 204 * MiB, WS_AV = 240 * MiB, WS_LFF = 276 * MiB, WS_LFB = 312 * MiB, WS_RI = 348 * MiB, WS_RQ = 384 * MiB, WS_AQ = 416 * MiB, WS_RG = 448 * MiB;
constexpr size_t WS_T = 204 * MiB, WS_Y = 348 * MiB, WS_ATT = 68 * MiB;
constexpr int C_MOD = 0, C_LAM = 110592, C_LBF = 110608, C_LBB = 111632, C_COS = 112656, C_SIN = 113680, C_CTR = 114704;
constexpr size_t CTL_ZERO_BYTES = 1 * MiB;
constexpr int LDS_BYTES = 147456, XB_LDS_OFF = LDS_BYTES - 64;
constexpr int C_BAR = 131072;

DI unsigned cvtpk(float lo, float hi) { f32x2 v = {lo, hi}; bf16x2_t b = __builtin_convertvector(v, bf16x2_t); return __builtin_bit_cast(unsigned, b); }
DI unsigned cvtpk_h(float lo, float hi) { f32x2 v = {lo, hi}; h16x2_t b = __builtin_convertvector(v, h16x2_t); return __builtin_bit_cast(unsigned, b); }
DI float bf2f(u16 b) { return __uint_as_float((unsigned)b << 16); }
DI float bflo(unsigned w) { return __uint_as_float(w << 16); }
DI float bfhi(unsigned w) { return __uint_as_float(w & 0xffff0000u); }
DI u16 f2bf(float f) { return (u16)(cvtpk(f, 0.f) & 0xffffu); }
DI float h2f(u16 h) { return (float)__builtin_bit_cast(_Float16, h); }
DI float fexp(float x) { return __builtin_amdgcn_exp2f(x * 1.4426950408889634f); }
DI float sigm(float x) { return __builtin_amdgcn_rcpf(1.f + fexp(-x)); }
DI float silu_(float x) { return x * sigm(x); }
DI float wave_sum(float v) {
#pragma unroll
  for (int o = 1; o < 64; o <<= 1) v += __shfl_xor(v, o);
  return v;
}
#define LDS_WAIT() asm volatile("s_waitcnt lgkmcnt(0)" ::: "memory")

namespace pg8 {
#define PG8_LAS __attribute__((address_space(3)))
typedef unsigned short bf16_t;
typedef short bf16x8 __attribute__((ext_vector_type(8)));
typedef float f32x4 __attribute__((ext_vector_type(4)));
typedef unsigned u32x4 __attribute__((ext_vector_type(4)));
constexpr int BM = 256, BK = 64, HALF = 128, HTB = HALF * BK * 2  , STAGE_BYTES = 8 * HTB, NXCD = 8, WGM = 4;

__host__ __device__ __forceinline__ int lds_byte(int r, int c) { const int st = (r >> 4) * 2 + (c >> 5), rr = r & 15, cc = c & 31, ob = rr * 64 + cc * 2; return st * 1024 + (ob ^ (((ob >> 9) & 1) << 5)); }
__host__ __device__ __forceinline__ void stage_rc(int b, int& R, int& C) { const int st = b / 1024, sb = b % 1024, swz = sb ^ (((sb >> 9) & 1) << 5); R = (st >> 1) * 16 + swz / 64; C = (st & 1) * 32 + (swz % 64) / 2; }
__host__ __device__ __forceinline__ int perm32(int rho) { const int n = rho >> 4, i = rho & 15; return 8 * (i >> 2) + 4 * n + (i & 3); }

struct Unit { int pm, pn; };
struct Gemm { const bf16_t* A; const bf16_t* Bt; int M, N, K, lda; };

struct StaticOrder {
    int nM, nN, nwg, G, c;
    __host__ __device__ void init(int M, int N, int G_, int c_) { nM = M / BM; nN = N / BM; nwg = nM * nN; G = G_; c = c_; }
    __host__ __device__ bool next(int i, Unit& u) const {
        const long L = (long)i * G + c; if (L >= nwg) return false;
        int wgid = (int)L; { const int q = nwg / NXCD, r = nwg % NXCD, xcd = wgid % NXCD, off = wgid / NXCD; wgid = (xcd < r ? xcd * (q + 1) : r * (q + 1) + (xcd - r) * q) + off; }
        const int nig = WGM * nN, gid = wgid / nig, fm = gid * WGM, gsz = (nM - fm) < WGM ? (nM - fm) : WGM;
        u.pm = fm + ((wgid % nig) % gsz); u.pn = (wgid % nig) / gsz; return true;
    }
    __device__ __forceinline__ void a_ready(const Unit&) const {}
    __device__ __forceinline__ void done(const Unit&) const {}
};
typedef PG8_LAS unsigned char* LdsPtr;
__device__ __forceinline__ unsigned cvt_pk_bf16(float lo, float hi) { return cvtpk(lo, hi); }
template <class Epi, class Sched, bool ALIGN_EPI = false, bool SP2 = false>
__device__ __forceinline__ void gemm_phase(PG8_LAS unsigned char* lds, const Gemm g, const Sched& S, const Epi& E) {
    int tid_ = threadIdx.x; asm volatile("" : "+v"(tid_)); const int tid = tid_, wid = __builtin_amdgcn_readfirstlane(tid >> 6), lane = tid & 63, wr = wid >> 2, wc = wid & 3, fr = lane & 15, fq = lane >> 4;
    const int K = g.K, nt = K / BK;
    unsigned voffA[2], voffB[2];
#pragma unroll
    for (int i = 0; i < 2; ++i) { int R, C; stage_rc(tid * 16 + i * 8192, R, C); const int Rb = Epi::PERM ? ((R & ~31) + perm32(R & 31)) : R;
        voffA[i] = (unsigned)(R * g.lda + C) * 2u; voffB[i] = (unsigned)(Rb * K + C) * 2u; }
    const size_t kstep = (size_t)(BK * 2);
    const size_t hstepA = (size_t)HALF * g.lda * 2, hstepB = (size_t)HALF * K * 2;
    const size_t tstepA = 2 * hstepA, tstepB = 2 * hstepB;
    const unsigned ldsw = (unsigned)wid * 1024u;
    const int aoff = lds_byte(wr * 64 + fr, fq * 8), boff = lds_byte(wc * 32 + fr, fq * 8);
#define PG8_SA(b, h) (((b) * 2 + (h)) * HTB)
#define PG8_SB(b, h) ((4 + (b) * 2 + (h)) * HTB)
#define PG8_STAGE(bufoff, gbase, voff) do { _Pragma("unroll") for (int _i = 0; _i < 2; ++_i) \
        __builtin_amdgcn_global_load_lds((const unsigned*)((const char*)(gbase) + (voff)[_i]), (PG8_LAS unsigned*)(lds + (bufoff) + ldsw + _i * 8192), 16, 0, 0); } while (0)
#define PG8_LDA(dst, b, h) do { _Pragma("unroll") for (int m = 0; m < 4; ++m) _Pragma("unroll") for (int k = 0; k < 2; ++k) dst[m][k] = *(const PG8_LAS bf16x8*)(lds + PG8_SA(b, h) + aoff + m * 2048 + k * 1024); } while (0)
#define PG8_LDB(dst, b, h) do { _Pragma("unroll") for (int n = 0; n < 2; ++n) _Pragma("unroll") for (int k = 0; k < 2; ++k) dst[n][k] = *(const PG8_LAS bf16x8*)(lds + PG8_SB(b, h) + boff + n * 2048 + k * 1024); } while (0)
#define PG8_MMA(ai, bj, At, Bt) do { __builtin_amdgcn_s_setprio(1); _Pragma("unroll") for (int m = 0; m < 4; ++m) _Pragma("unroll") for (int n = 0; n < 2; ++n) _Pragma("unroll") for (int k = 0; k < 2; ++k) \
        acc[ai][bj][m][n] = __builtin_amdgcn_mfma_f32_16x16x32_bf16(Bt[n][k], At[m][k], acc[ai][bj][m][n], 0, 0, 0); __builtin_amdgcn_s_setprio(0); } while (0)
#define PG8_WAIT_V(n) asm volatile("s_waitcnt vmcnt(" #n ")" ::: "memory")
#define PG8_WAIT_L(n) asm volatile("s_waitcnt lgkmcnt(" #n ")" ::: "memory")
#define PG8_BAR __builtin_amdgcn_s_barrier()
#define PG8_SCHED __builtin_amdgcn_sched_barrier(0)
    Unit cur, nxt; int ui = 0;
    if (!S.next(0, cur)) return;
    f32x4 acc[2][2][4][2];
#pragma unroll
    for (int a = 0; a < 2; ++a)
#pragma unroll
        for (int b = 0; b < 2; ++b)
#pragma unroll
            for (int m = 0; m < 4; ++m)
#pragma unroll
                for (int n = 0; n < 2; ++n) acc[a][b][m][n] = (f32x4){0.f, 0.f, 0.f, 0.f};
    bf16x8 At[4][2], B0[2][2], B1[2][2];
    const char* cA = (const char*)g.A + (size_t)cur.pm * tstepA; const char* cB = (const char*)g.Bt + (size_t)cur.pn * tstepB;
    S.a_ready(cur);
    if constexpr (SP2) {
        PG8_STAGE(PG8_SB(0, 0), cB, voffB); PG8_STAGE(PG8_SB(0, 1), cB + hstepB, voffB); PG8_STAGE(PG8_SA(0, 0), cA, voffA); PG8_STAGE(PG8_SA(0, 1), cA + hstepA, voffA);
        if (wr == 1) PG8_BAR;
        PG8_WAIT_V(2); PG8_BAR;
        PG8_STAGE(PG8_SB(1, 0), cB + kstep, voffB); PG8_STAGE(PG8_SA(1, 0), cA + kstep, voffA); PG8_STAGE(PG8_SB(1, 1), cB + hstepB + kstep, voffB);
        PG8_WAIT_V(6); PG8_BAR;
    } else {
        PG8_STAGE(PG8_SB(0, 0), cB, voffB); PG8_STAGE(PG8_SA(0, 0), cA, voffA); PG8_STAGE(PG8_SB(0, 1), cB + hstepB, voffB); PG8_STAGE(PG8_SA(0, 1), cA + hstepA, voffA);
        if (wr == 1) PG8_BAR;
        PG8_WAIT_V(4); PG8_BAR;
        PG8_STAGE(PG8_SB(1, 0), cB + kstep, voffB); PG8_STAGE(PG8_SA(1, 0), cA + kstep, voffA); PG8_STAGE(PG8_SB(1, 1), cB + hstepB + kstep, voffB);
        PG8_WAIT_V(6); PG8_BAR;
    }
    for (;;) {
        const bool has_next = S.next(ui + 1, nxt);
        const char* nA = has_next ? (const char*)g.A + (size_t)nxt.pm * tstepA : cA; const char* nB = has_next ? (const char*)g.Bt + (size_t)nxt.pn * tstepB : cB;
        for (int t = 0; t < nt; t += 2) {
            const bool last = (t == nt - 2);
            const char* a1 = cA + (size_t)(t + 1) * kstep;
            const char* a2 = last ? nA : cA + (size_t)(t + 2) * kstep; const char* b2 = last ? nB : cB + (size_t)(t + 2) * kstep;
            const char* a3 = a2 + kstep; const char* b3 = b2 + kstep;
            if (last && has_next) S.a_ready(nxt);
            if constexpr (SP2) {
            PG8_LDB(B0, 0, 0); PG8_LDB(B1, 0, 1); PG8_SCHED; PG8_LDA(At, 0, 0); PG8_STAGE(PG8_SA(1, 1), a1 + hstepA, voffA);
            PG8_WAIT_V(8); PG8_WAIT_L(0); PG8_BAR; PG8_MMA(0, 0, At, B0); PG8_MMA(0, 1, At, B1); PG8_BAR; PG8_SCHED;
            PG8_LDA(At, 0, 1); PG8_STAGE(PG8_SB(0, 0), b2, voffB); PG8_STAGE(PG8_SB(0, 1), b2 + hstepB, voffB); PG8_STAGE(PG8_SA(0, 0), a2, voffA);
            PG8_WAIT_V(8); PG8_WAIT_L(0); PG8_BAR; PG8_MMA(1, 0, At, B0); PG8_MMA(1, 1, At, B1); PG8_BAR; PG8_SCHED;
            PG8_LDB(B0, 1, 0); PG8_LDB(B1, 1, 1); PG8_SCHED; PG8_LDA(At, 1, 0); PG8_STAGE(PG8_SA(0, 1), a2 + hstepA, voffA);
            PG8_WAIT_V(8); PG8_WAIT_L(0); PG8_BAR; PG8_MMA(0, 0, At, B0); PG8_MMA(0, 1, At, B1); PG8_BAR; PG8_SCHED;
            PG8_LDA(At, 1, 1); PG8_STAGE(PG8_SB(1, 0), b3, voffB); PG8_STAGE(PG8_SB(1, 1), b3 + hstepB, voffB); PG8_STAGE(PG8_SA(1, 0), a3, voffA);
            PG8_WAIT_V(8); PG8_WAIT_L(0); PG8_BAR; PG8_MMA(1, 0, At, B0); PG8_MMA(1, 1, At, B1); PG8_BAR; PG8_SCHED;
            } else {
            PG8_LDB(B0, 0, 0); PG8_SCHED; PG8_LDA(At, 0, 0); PG8_STAGE(PG8_SA(1, 1), a1 + hstepA, voffA);
            PG8_WAIT_L(8); PG8_BAR; PG8_WAIT_L(0); PG8_MMA(0, 0, At, B0); PG8_BAR; PG8_SCHED;
            PG8_LDB(B1, 0, 1); PG8_STAGE(PG8_SB(0, 0), b2, voffB);
            PG8_BAR; PG8_WAIT_L(0); PG8_MMA(0, 1, At, B1); PG8_BAR;
            PG8_LDA(At, 0, 1); PG8_STAGE(PG8_SA(0, 0), a2, voffA);
            PG8_BAR; PG8_WAIT_L(0); PG8_MMA(1, 0, At, B0); PG8_BAR; PG8_SCHED;
            PG8_STAGE(PG8_SB(0, 1), b2 + hstepB, voffB);
            PG8_WAIT_V(6); PG8_BAR; PG8_MMA(1, 1, At, B1); PG8_BAR;
            PG8_LDB(B0, 1, 0); PG8_SCHED; PG8_LDA(At, 1, 0); PG8_STAGE(PG8_SA(0, 1), a2 + hstepA, voffA);
            PG8_WAIT_L(8); PG8_BAR; PG8_WAIT_L(0); PG8_MMA(0, 0, At, B0); PG8_BAR; PG8_SCHED;
            PG8_LDB(B1, 1, 1); PG8_STAGE(PG8_SB(1, 0), b3, voffB);
            PG8_BAR; PG8_WAIT_L(0); PG8_MMA(0, 1, At, B1); PG8_BAR;
            PG8_LDA(At, 1, 1); PG8_STAGE(PG8_SA(1, 0), a3, voffA);
            PG8_BAR; PG8_WAIT_L(0); PG8_MMA(1, 0, At, B0); PG8_BAR; PG8_SCHED;
            PG8_STAGE(PG8_SB(1, 1), b3 + hstepB, voffB);
            PG8_WAIT_V(6); PG8_BAR; PG8_MMA(1, 1, At, B1); PG8_BAR;
            }
        }
        if constexpr (ALIGN_EPI) { if (wr == 0) PG8_BAR; }
        if constexpr (!Epi::AFTER_DRAIN) { E(acc, cur, wr, wc, fr, fq); S.done(cur); }
        if (!has_next) break;
#pragma unroll
        for (int a = 0; a < 2; ++a)
#pragma unroll
            for (int b = 0; b < 2; ++b)
#pragma unroll
                for (int m = 0; m < 4; ++m)
#pragma unroll
                    for (int n = 0; n < 2; ++n) acc[a][b][m][n] = (f32x4){0.f, 0.f, 0.f, 0.f};
        cur = nxt; cA = nA; cB = nB; ++ui;
        if constexpr (ALIGN_EPI) { if (wr == 1) PG8_BAR; }
    }
    PG8_WAIT_V(0);
    if constexpr (!ALIGN_EPI) { if (wr == 0) PG8_BAR; }
    PG8_BAR;
    if constexpr (Epi::AFTER_DRAIN) { E.fused(acc, cur, wr, wc, fr, fq, lds, wid, lane); S.done(cur); }
#undef PG8_SA
#undef PG8_SB
#undef PG8_STAGE
#undef PG8_LDA
#undef PG8_LDB
#undef PG8_MMA
#undef PG8_WAIT_V
#undef PG8_WAIT_L
#undef PG8_BAR
#undef PG8_SCHED
}
struct OrderIn {
    StaticOrder so; int G, c;
    __device__ void init(int G_, int c_) { so.init(16384, 12288, G_, c_); G = G_; c = c_; }
    __device__ bool next(int i, Unit& u) const {
        if (so.next(i, u)) return true;
        const long L = (long)i * G + c - 3072; if (L < 0 || L >= 160) return false;
        u.pm = 64 + (int)(L & 7); u.pn = (int)(L >> 3); return true;
    }
    __device__ __forceinline__ void a_ready(const Unit&) const {}
    __device__ __forceinline__ void done(const Unit&) const {}
};

struct EpiIn {
    static constexpr bool PERM = true, AFTER_DRAIN = false;
    u16 *AK, *AV, *LFF, *LFB, *RI, *AQ, *RQ, *RG, *GATES; const float *lbf, *lbb, *rcos, *rsin;
    template <int MODE> __device__ __forceinline__ void run(const f32x4 (&acc)[2][2][4][2], u16* dst, int ld, int row0, int col0, int trow0, int wc, int fq, const float* lb) const {
        f32x4 lb0[2], lb1[2];
        if (MODE == 3) {
#pragma unroll
            for (int bj = 0; bj < 2; ++bj) { lb0[bj] = *(const f32x4*)(lb + col0 + bj * HALF); lb1[bj] = *(const f32x4*)(lb + col0 + bj * HALF + 4); }
        }
#pragma unroll
        for (int ai = 0; ai < 2; ++ai)
#pragma unroll
            for (int m = 0; m < 4; ++m) {
                const int rr = ai * HALF + m * 16;
                u16* rowp = dst + (size_t)(row0 + rr) * ld + col0;
                f32x4 cs, sn;
                if (MODE == 1 || MODE == 2) { const int t = trow0 + rr; const int pos = (wc & 1) ? (t & 63) : (t >> 6);
                    cs = *(const f32x4*)(rcos + pos * 16 + 4 * fq); sn = *(const f32x4*)(rsin + pos * 16 + 4 * fq); }
#pragma unroll
                for (int bj = 0; bj < 2; ++bj) {
                    f32x4 v0 = acc[ai][bj][m][0], v1 = acc[ai][bj][m][1];
                    if (MODE == 1 || MODE == 2) { const f32x4 a = v0 * cs - v1 * sn, b = v1 * cs + v0 * sn; v0 = a; v1 = b;
                        if (MODE == 2) { v0 = v0 * 0.18033688011112042f; v1 = v1 * 0.18033688011112042f; } }
                    if (MODE == 3) {
#pragma unroll
                        for (int i = 0; i < 4; ++i) { const float l0 = lb0[bj][i], l1 = lb1[bj][i];
                            v0[i] = __logf(l0 + (1.f - l0) * sigm(v0[i])); v1[i] = __logf(l1 + (1.f - l1) * sigm(v1[i])); }
                    }
                    if (MODE == 4) {
#pragma unroll
                        for (int i = 0; i < 4; ++i) { v0[i] = silu_(v0[i]); v1[i] = silu_(v1[i]); }
                    }
                    if (MODE == 5) {
#pragma unroll
                        for (int i = 0; i < 4; ++i) { v0[i] = sigm(v0[i]); v1[i] = sigm(v1[i]); }
                    }
                    u32x4 w;
                    if (MODE == 3) { w.x = cvtpk_h(v0[0], v0[1]); w.y = cvtpk_h(v0[2], v0[3]); w.z = cvtpk_h(v1[0], v1[1]); w.w = cvtpk_h(v1[2], v1[3]); }
                    else { w.x = cvtpk(v0[0], v0[1]); w.y = cvtpk(v0[2], v0[3]); w.z = cvtpk(v1[0], v1[1]); w.w = cvtpk(v1[2], v1[3]); }
                    *(u32x4*)(rowp + bj * HALF) = w;
                }
            }
    }
    __device__ __forceinline__ void operator()(const f32x4 (&acc)[2][2][4][2], const Unit& u, int wr, int wc, int fr, int fq) const {
        const int pm = u.pm, pn = u.pn; const bool ctx = pm >= 64;
        const int b = ctx ? pm - 64 : (pm >> 3);
        const int trow0 = (ctx ? 0 : (pm & 7) * 256) + wr * 64 + fr;
        const int kvrow0 = b * TKV + (ctx ? SEQ : 0) + trow0;
        const int latrow0 = pm * 256 + wr * 64 + fr;
        const int seg = pn >> 2, c1 = (pn & 3) * 256 + wc * 32 + 8 * fq;
        switch (seg) {
        case 0: if (ctx) run<0>(acc, AK, 1024, kvrow0, c1, trow0, wc, fq, nullptr); else run<1>(acc, AK, 1024, kvrow0, c1, trow0, wc, fq, nullptr); break;
        case 1: run<0>(acc, AV, 1024, kvrow0, c1, trow0, wc, fq, nullptr); break;
        case 2: run<3>(acc, LFF, 1024, kvrow0, c1, trow0, wc, fq, lbf); break;
        case 3: run<3>(acc, LFB, 1024, kvrow0, c1, trow0, wc, fq, lbb); break;
        case 4: run<0>(acc, RI, 1024, kvrow0, c1, trow0, wc, fq, nullptr); break;
        case 5: run<2>(acc, AQ, 1024, latrow0, c1, trow0, wc, fq, nullptr); break;
        case 6: run<4>(acc, RQ, 1024, latrow0, c1, trow0, wc, fq, nullptr); break;
        case 7: run<4>(acc, RG, 1024, latrow0, c1, trow0, wc, fq, nullptr); break;
        default: run<5>(acc, GATES, 4096, latrow0, (pn - 32) * 256 + wc * 32 + 8 * fq, trow0, wc, fq, nullptr); break;
        }
    }
};
struct EpiMergeA {
    static constexpr bool PERM = true, AFTER_DRAIN = false;
    const u16* GATES; u16* T;
    __device__ __forceinline__ void operator()(const f32x4 (&acc)[2][2][4][2], const Unit& u, int wr, int wc, int fr, int fq) const {
        const int row0 = u.pm * BM + wr * 64 + fr, col0 = u.pn * BM + wc * 32 + 8 * fq;
#pragma unroll
        for (int ai = 0; ai < 2; ++ai)
#pragma unroll
            for (int m = 0; m < 4; ++m) { const size_t r = (size_t)(row0 + ai * HALF + m * 16);
#pragma unroll
                for (int bj = 0; bj < 2; ++bj) { const int c = col0 + bj * HALF;
                    const u32x4 g = *(const u32x4*)(GATES + r * 4096 + c);
                    const f32x4 v0 = acc[ai][bj][m][0], v1 = acc[ai][bj][m][1];
                    u32x4 w; w.x = cvtpk(v0[0] * bflo(g.x), v0[1] * bfhi(g.x)); w.y = cvtpk(v0[2] * bflo(g.y), v0[3] * bfhi(g.y));
                    w.z = cvtpk(v1[0] * bflo(g.z), v1[1] * bfhi(g.z)); w.w = cvtpk(v1[2] * bflo(g.w), v1[3] * bfhi(g.w));
                    *(u32x4*)(T + r * 2048 + c) = w; } }
    }
};
struct EpiMergeB {
    static constexpr bool PERM = true, AFTER_DRAIN = false;
    const u16* GATES; const u16* T; u16* Y;
    __device__ __forceinline__ void operator()(const f32x4 (&acc)[2][2][4][2], const Unit& u, int wr, int wc, int fr, int fq) const {
        const int row0 = u.pm * BM + wr * 64 + fr, col0 = u.pn * BM + wc * 32 + 8 * fq;
#pragma unroll
        for (int ai = 0; ai < 2; ++ai)
#pragma unroll
            for (int m = 0; m < 4; ++m) { const size_t r = (size_t)(row0 + ai * HALF + m * 16);
#pragma unroll
                for (int bj = 0; bj < 2; ++bj) { const int c = col0 + bj * HALF;
                    const u32x4 g = *(const u32x4*)(GATES + r * 4096 + 2048 + c);
                    const u32x4 t = *(const u32x4*)(T + r * 2048 + c);
                    const f32x4 v0 = acc[ai][bj][m][0], v1 = acc[ai][bj][m][1];
                    u32x4 w; w.x = cvtpk(bflo(t.x) + v0[0] * bflo(g.x), bfhi(t.x) + v0[1] * bfhi(g.x)); w.y = cvtpk(bflo(t.y) + v0[2] * bflo(g.y), bfhi(t.y) + v0[3] * bfhi(g.y));
                    w.z = cvtpk(bflo(t.z) + v1[0] * bflo(g.z), bfhi(t.z) + v1[1] * bfhi(g.z)); w.w = cvtpk(bflo(t.w) + v1[2] * bflo(g.w), bfhi(t.w) + v1[3] * bfhi(g.w));
                    *(u32x4*)(Y + r * 2048 + c) = w; } }
    }
};
struct EpiRes {
    static constexpr bool PERM = false, AFTER_DRAIN = false;
    const float* base; float* out; const float* gate;
    __device__ __forceinline__ void operator()(const f32x4 (&acc)[2][2][4][2], const Unit& u, int wr, int wc, int fr, int fq) const {
        const int row0 = u.pm * BM + wr * 64 + fr, col0 = u.pn * BM + wc * 32 + 4 * fq;
        const float* gb = gate + (size_t)(u.pm >> 3) * NIN;
        f32x4 gv[2][2];
#pragma unroll
        for (int bj = 0; bj < 2; ++bj)
#pragma unroll
            for (int n = 0; n < 2; ++n) gv[bj][n] = *(const f32x4*)(gb + col0 + bj * HALF + n * 16);
#pragma unroll
        for (int ai = 0; ai < 2; ++ai)
#pragma unroll
            for (int m = 0; m < 4; ++m) { const size_t off = (size_t)(row0 + ai * HALF + m * 16) * 2048 + col0;
#pragma unroll
                for (int bj = 0; bj < 2; ++bj)
#pragma unroll
                    for (int n = 0; n < 2; ++n) { const f32x4 bs = *(const f32x4*)(base + off + bj * HALF + n * 16);
                        *(f32x4*)(out + off + bj * HALF + n * 16) = bs + gv[bj][n] * acc[ai][bj][m][n]; } }
    }
};
struct EpiUp {
    static constexpr bool PERM = true, AFTER_DRAIN = false;
    u16* U; u16* SIDE;
    __device__ __forceinline__ void operator()(const f32x4 (&acc)[2][2][4][2], const Unit& u, int wr, int wc, int fr, int fq) const {
        const int row0 = u.pm * BM + wr * 64 + fr, col0 = u.pn * BM + wc * 32 + 8 * fq;
#pragma unroll
        for (int ai = 0; ai < 2; ++ai)
#pragma unroll
            for (int m = 0; m < 4; ++m) { const int r = row0 + ai * HALF + m * 16;
                const bool first = ((m & 1) == 0) && fr == 0, last = ((m & 1) == 1) && fr == 15;
#pragma unroll
                for (int bj = 0; bj < 2; ++bj) { const int c = col0 + bj * HALF;
                    const f32x4 v0 = acc[ai][bj][m][0], v1 = acc[ai][bj][m][1];
                    u32x4 w; w.x = cvtpk(v0[0], v0[1]); w.y = cvtpk(v0[2], v0[3]); w.z = cvtpk(v1[0], v1[1]); w.w = cvtpk(v1[2], v1[3]);
                    *(u32x4*)(U + (size_t)r * FF2 + c) = w;
                    if (first) *(u32x4*)(SIDE + ((size_t)(r >> 5) * 2 + 0) * FF2 + c) = w;
                    if (last)  *(u32x4*)(SIDE + ((size_t)(r >> 5) * 2 + 1) * FF2 + c) = w; } }
    }
};
struct EpiNone {
    static constexpr bool PERM = true, AFTER_DRAIN = false; float* sink;
    __device__ __forceinline__ void operator()(const f32x4 (&acc)[2][2][4][2], const Unit& u, int wr, int wc, int fr, int fq) const {
        f32x4 s = acc[0][0][0][0];
#pragma unroll
        for (int ai = 0; ai < 2; ++ai)
#pragma unroll
            for (int bj = 0; bj < 2; ++bj)
#pragma unroll
                for (int m = 0; m < 4; ++m)
#pragma unroll
                    for (int n = 0; n < 2; ++n) s += acc[ai][bj][m][n];
        if (s[0] + s[1] + s[2] + s[3] == 1.2345e30f) sink[0] = s[0];
    }
};
struct OneUnit {
    Unit u;
    __device__ bool next(int i, Unit& o) const { if (i != 0) return false; o = u; return true; }
    __device__ __forceinline__ void a_ready(const Unit&) const {}
    __device__ __forceinline__ void done(const Unit&) const {}
};
struct EpiConv {
    static constexpr bool PERM = true, AFTER_DRAIN = true;
    u16* Gt; u16* SIDE2; const float* cw; const float* cbv;
    __device__ __forceinline__ void fused(f32x4 (&acc)[2][2][4][2], const Unit& u, int wr, int wc, int fr, int fq, PG8_LAS unsigned char* lds, int wid, int lane) const {
#pragma unroll
        for (int ai = 0; ai < 2; ++ai)
#pragma unroll
            for (int m = 0; m < 4; ++m) { const int row = ai * HALF + wr * 64 + m * 16 + fr;
#pragma unroll
                for (int bj = 0; bj < 2; ++bj) { const int chunk = 16 * bj + 4 * wc + fq;
                    const f32x4 v0 = acc[ai][bj][m][0], v1 = acc[ai][bj][m][1];
                    u32x4 w; w.x = cvtpk(v0[0], v0[1]); w.y = cvtpk(v0[2], v0[3]); w.z = cvtpk(v1[0], v1[1]); w.w = cvtpk(v1[2], v1[3]);
                    *(PG8_LAS u32x4*)(lds + row * 512 + ((chunk ^ (row & 31)) << 4)) = w; } }
        __syncthreads();
        const int t = wid * 64 + lane, c8 = t & 15, rg = t >> 4, f = u.pn * 128 + c8 * 8;
        float wa[3][8], wb[3][8], ba[8], bb[8];
#pragma unroll
        for (int j = 0; j < 3; ++j)
#pragma unroll
            for (int i = 0; i < 8; ++i) { wa[j][i] = cw[j * FF2 + f + i]; wb[j][i] = cw[j * FF2 + FF + f + i]; }
#pragma unroll
        for (int i = 0; i < 8; ++i) { ba[i] = cbv[f + i]; bb[i] = cbv[FF + f + i]; }
        float pa[8], pb[8], ca[8], cb[8], na[8], nb[8];
#define CONV_LD(DA, DB, q_) do { const int q__ = (q_); if (q__ >= 0 && q__ < 256) { \
            const u32x4 xa_ = *(const PG8_LAS u32x4*)(lds + q__ * 512 + ((c8 ^ (q__ & 31)) << 4)), xb_ = *(const PG8_LAS u32x4*)(lds + q__ * 512 + (((16 + c8) ^ (q__ & 31)) << 4)); \
            _Pragma("unroll") for (int i_ = 0; i_ < 4; ++i_) { DA[2 * i_] = bflo(xa_[i_]); DA[2 * i_ + 1] = bfhi(xa_[i_]); DB[2 * i_] = bflo(xb_[i_]); DB[2 * i_ + 1] = bfhi(xb_[i_]); } } \
          else { _Pragma("unroll") for (int i_ = 0; i_ < 8; ++i_) { DA[i_] = 0.f; DB[i_] = 0.f; } } } while (0)
        CONV_LD(pa, pb, rg * 8 - 1); CONV_LD(ca, cb, rg * 8);
#pragma unroll
        for (int i8 = 0; i8 < 8; ++i8) { const int r = rg * 8 + i8;
            CONV_LD(na, nb, r + 1);
            u32x4 o;
#pragma unroll
            for (int i = 0; i < 4; ++i) {
                const float a0 = ba[2 * i] + wa[0][2 * i] * pa[2 * i] + wa[1][2 * i] * ca[2 * i] + wa[2][2 * i] * na[2 * i];
                const float a1 = ba[2 * i + 1] + wa[0][2 * i + 1] * pa[2 * i + 1] + wa[1][2 * i + 1] * ca[2 * i + 1] + wa[2][2 * i + 1] * na[2 * i + 1];
                const float b0 = bb[2 * i] + wb[0][2 * i] * pb[2 * i] + wb[1][2 * i] * cb[2 * i] + wb[2][2 * i] * nb[2 * i];
                const float b1 = bb[2 * i + 1] + wb[0][2 * i + 1] * pb[2 * i + 1] + wb[1][2 * i + 1] * cb[2 * i + 1] + wb[2][2 * i + 1] * nb[2 * i + 1];
                o[i] = cvtpk(silu_(a0) * b0, silu_(a1) * b1); }
            *(u32x4*)(Gt + (size_t)(u.pm * BM + r) * FF + f) = o;
#pragma unroll
            for (int i = 0; i < 8; ++i) { pa[i] = ca[i]; pb[i] = cb[i]; ca[i] = na[i]; cb[i] = nb[i]; } }
#undef CONV_LD
        if (t < 128) { const int rr = t >> 5, ch = t & 31, row = (rr < 2) ? rr : 252 + rr;
            const u32x4 v = *(const PG8_LAS u32x4*)(lds + row * 512 + ((ch ^ (row & 31)) << 4));
            *(u32x4*)(SIDE2 + ((size_t)(u.pm * 44 + u.pn) * 4 + rr) * 256 + ch * 8) = v; }
        __syncthreads();
    }
};
}

#define KSWZ(row, colB) ((row) * 256 + ((colB) ^ (((row) & 7) << 4)))
#define SBAR() __builtin_amdgcn_sched_barrier(0)
#define MFMA32(a, b, c) __builtin_amdgcn_mfma_f32_32x32x16_bf16((a), (b), (c), 0, 0, 0)
DI int crow(int r, int hi) { return (r & 3) + 8 * (r >> 2) + 4 * hi; }
DI int v_st(int k, int c) { const int kk = (k & ~0xC) | ((k & 4) << 1) | ((k & 8) >> 1); return ((kk >> 3) * 4 + (c >> 5)) * 512 + ((kk & 7) * 32 + (c & 31)) * 2; }
DI int v_rd_base(int lane) { return ((lane & 3) << 3) | (((lane >> 2) & 3) << 6) | (((lane >> 4) & 1) << 5) | (((lane >> 5) & 1) << 8); }
constexpr int v_rd_off(int d0, int ks, int half) { return d0 * 512 + ks * 4096 + half * 2048; }
typedef short v4i16_t __attribute__((ext_vector_type(4)));
typedef LAS const char* lds_cptr;
DI s16x4 vtr(lds_cptr p) { return __builtin_bit_cast(s16x4, __builtin_amdgcn_ds_read_tr16_b64_v4i16((LAS v4i16_t*)p)); }
#define PKF(L, H) (s16x8){L[0], L[1], L[2], L[3], H[0], H[1], H[2], H[3]}
DI void pv_blk(f32x16& od, int vb, s16x8 pa0, s16x8 pa1, s16x8 pa2, s16x8 pa3) {
  const lds_cptr p = (lds_cptr)(uintptr_t)(unsigned)vb;
  const s16x4 l0 = vtr(p + v_rd_off(0, 0, 0)), h0 = vtr(p + v_rd_off(0, 0, 1)), l1 = vtr(p + v_rd_off(0, 1, 0)), h1 = vtr(p + v_rd_off(0, 1, 1));
  const s16x4 l2 = vtr(p + v_rd_off(0, 2, 0)), h2 = vtr(p + v_rd_off(0, 2, 1)), l3 = vtr(p + v_rd_off(0, 3, 0)), h3 = vtr(p + v_rd_off(0, 3, 1));
  od = MFMA32(pa0, PKF(l0, h0), od); od = MFMA32(pa1, PKF(l1, h1), od); od = MFMA32(pa2, PKF(l2, h2), od); od = MFMA32(pa3, PKF(l3, h3), od);
}
DI void tt_blk(f32x16& od, int ab, int vb) {
  const lds_cptr pa = (lds_cptr)(uintptr_t)(unsigned)ab, p = (lds_cptr)(uintptr_t)(unsigned)vb;
#pragma unroll
  for (int ks = 0; ks < 4; ++ks) {
    const s16x4 a0 = vtr(pa + v_rd_off(0, ks, 0)), a1 = vtr(pa + v_rd_off(0, ks, 1)), l0 = vtr(p + v_rd_off(0, ks, 0)), h0 = vtr(p + v_rd_off(0, ks, 1));
    od = MFMA32(PKF(a0, a1), PKF(l0, h0), od); }
}
#define PK4(P, BASE, OUT) do { unsigned a0_ = cvtpk(P[BASE + 0], P[BASE + 1]), a1_ = cvtpk(P[BASE + 2], P[BASE + 3]);   \
    unsigned b0_ = cvtpk(P[BASE + 4], P[BASE + 5]), b1_ = cvtpk(P[BASE + 6], P[BASE + 7]);                              \
    auto r0_ = __builtin_amdgcn_permlane32_swap(a0_, b0_, false, false); auto r1_ = __builtin_amdgcn_permlane32_swap(a1_, b1_, false, false); \
    u32x4v w_ = {r0_[0], r1_[0], r0_[1], r1_[1]}; OUT = __builtin_bit_cast(s16x8, w_); } while (0)

constexpr float ATT_THR = 8.f;
DI void partialSM(f32x16& p0, f32x16& p1, float& m_reg, f32x16& negm, float& alpha) {
  float pmax = fmaxf(p0[0], p0[1]);
#pragma unroll
  for (int r = 2; r < 16; ++r) pmax = fmaxf(pmax, p0[r]);
#pragma unroll
  for (int r = 0; r < 16; ++r) pmax = fmaxf(pmax, p1[r]);
  { auto rr = __builtin_amdgcn_permlane32_swap(__float_as_uint(pmax), __float_as_uint(pmax), false, false);
    pmax = fmaxf(__uint_as_float(rr[0]), __uint_as_float(rr[1])); }
  alpha = 1.f;
  if (__builtin_expect(!__all(pmax <= ATT_THR), 0)) {
    const float dl = fmaxf(pmax, 0.f); m_reg += dl; alpha = __builtin_amdgcn_exp2f(-dl);
#pragma unroll
    for (int r = 0; r < 16; ++r) { p0[r] -= dl; p1[r] -= dl; negm[r] = -m_reg; }
  }
#pragma unroll
  for (int r = 0; r < 16; ++r) p0[r] = __builtin_amdgcn_exp2f(p0[r]);
}
DI void finishSM(f32x16& p0, f32x16& p1, float alpha, float& l_reg, s16x8& pa0, s16x8& pa1, s16x8& pa2, s16x8& pa3) {
#pragma unroll
  for (int r = 0; r < 16; ++r) p1[r] = __builtin_amdgcn_exp2f(p1[r]);
  float ps = 0;
#pragma unroll
  for (int r = 0; r < 16; ++r) ps += p0[r];
#pragma unroll
  for (int r = 0; r < 16; ++r) ps += p1[r];
  { auto rr = __builtin_amdgcn_permlane32_swap(__float_as_uint(ps), __float_as_uint(ps), false, false);
    ps = __uint_as_float(rr[0]) + __uint_as_float(rr[1]); }
  l_reg = l_reg * alpha + ps;
  PK4(p0, 0, pa0); PK4(p0, 8, pa1); PK4(p1, 0, pa2); PK4(p1, 8, pa3);
}
DI void qkt64(f32x16& p0, f32x16& p1, const char* Ks, const s16x8* qr, const f32x16& negm, int comp, int r32, int hi) {
#pragma unroll
  for (int d0 = 0; d0 < 4; ++d0) { const int cb = (comp * 64 + d0 * 16 + hi * 8) * 2;
    const s16x8 b0 = *(const s16x8*)(Ks + KSWZ(r32, cb));
    const s16x8 b1 = *(const s16x8*)(Ks + KSWZ(32 + r32, cb));
    if (d0 == 0) { p0 = MFMA32(b0, qr[0], negm); p1 = MFMA32(b1, qr[0], negm); }
    else { p0 = MFMA32(b0, qr[d0], p0); p1 = MFMA32(b1, qr[d0], p1); } }
}
constexpr int SHM_V = 16384, SHM_K = 16384, ATT_KOFF = 3 * SHM_V, ATT_WS = 3 * SHM_V + 2 * SHM_K  , ATT_X = 0  , ATT_CTR = 135168  ;
DI void pv_all(f32x16* o, int vb, s16x8 pa0, s16x8 pa1, s16x8 pa2, s16x8 pa3) {
  const lds_cptr p = (lds_cptr)(uintptr_t)(unsigned)vb;
  const s16x8 pa[4] = {pa0, pa1, pa2, pa3};
#pragma unroll
  for (int ks = 0; ks < 4; ++ks)
#pragma unroll
    for (int d0 = 0; d0 < 4; ++d0) { const s16x4 l = vtr(p + v_rd_off(d0, ks, 0)), h = vtr(p + v_rd_off(d0, ks, 1)); o[d0] = MFMA32(pa[ks], PKF(l, h), o[d0]); }
}
template <int AV_> DI void attn_unit(const u16* __restrict__ Qb, u16* __restrict__ Ob, const u16* __restrict__ Kh, const u16* __restrict__ Vh, float lam, const float* __restrict__ subw, char* lds) {
  constexpr int LDK = 1024;
  int tid_ = threadIdx.x; asm volatile("" : "+v"(tid_)); const int tid = tid_, wid = __builtin_amdgcn_readfirstlane(tid >> 6), lane = tid & 63, r32 = lane & 31, hi = lane >> 5;
  const int rb = wid >> 1, comp = wid & 1;
  char* V_lds = lds; char* K_lds = lds + ATT_KOFF;
  float* ws = (float*)(lds + ATT_WS) + wid * 64; float* li_l = ws; float* al_l = ws + 32;
  float m_reg = 0.f, l_reg = 0; f32x16 o[4] = {}; s16x8 qr[4]; f32x16 negm = {};
  const u16* Qw = Qb + (size_t)(rb * 32 + r32) * LDK + comp * 64 + hi * 8;
#pragma unroll
  for (int d0 = 0; d0 < 4; ++d0) qr[d0] = *(const s16x8*)(Qw + d0 * 16);
  const int vb0 = (int)(uintptr_t)V_lds + v_rd_base(lane);
  const char* ksrc[2]; const char* vsrc[2];
#pragma unroll
  for (int i = 0; i < 2; ++i) { const int q = wid + 8 * i;
    { const int row = 4 * q + (lane >> 4), colB = ((lane & 15) * 16) ^ ((row & 7) << 4); ksrc[i] = (const char*)(Kh + (size_t)row * LDK) + colB; }
    { const int st = 2 * q + (lane >> 5), kkx = (st >> 2) * 8 + ((lane & 31) >> 2), c = (st & 3) * 32 + (lane & 3) * 8;
      const int key = (kkx & ~0xC) | ((kkx & 4) << 1) | ((kkx & 8) >> 1); vsrc[i] = (const char*)(Vh + (size_t)key * LDK + c); } }
  const LAS unsigned char* ldsb = (const LAS unsigned char*)lds;
#define SDMA(k0, kb_, vb_) do { const size_t go_ = (size_t)(k0) * LDK * 2; _Pragma("unroll") for (int i_ = 0; i_ < 2; ++i_) { \
    __builtin_amdgcn_global_load_lds((const unsigned*)(ksrc[i_] + go_), (LAS unsigned*)(ldsb + ATT_KOFF + (kb_) * SHM_K + (wid + 8 * i_) * 1024), 16, 0, 0); \
    __builtin_amdgcn_global_load_lds((const unsigned*)(vsrc[i_] + go_), (LAS unsigned*)(ldsb + (vb_) * SHM_V + (wid + 8 * i_) * 1024), 16, 0, 0); } } while (0)
#define SLAND() asm volatile("s_waitcnt vmcnt(0)" ::: "memory")
#define RESCALE(al_) do { if (__any((al_) < 1.f)) { if (hi == 0) al_l[r32] = (al_); LDS_WAIT(); \
    _Pragma("unroll") for (int d = 0; d < 4; ++d) _Pragma("unroll") for (int r = 0; r < 16; ++r) o[d][r] *= al_l[crow(r, hi)]; } } while (0)
  constexpr int NT = TKV / 64;
  f32x16 pA0, pA1, pB0, pB1; float alA, alB; s16x8 pa0, pa1, pa2, pa3;
  SDMA(0, 0, 0); SLAND(); __syncthreads();
  SDMA(64, 1, 1);
  qkt64(pA0, pA1, K_lds, qr, negm, comp, r32, hi); partialSM(pA0, pA1, m_reg, negm, alA);
  SLAND(); __syncthreads();
  int vprev = 0, vnext = 2;
#define VROT() do { vprev = (vprev == 2) ? 0 : vprev + 1; vnext = (vnext == 2) ? 0 : vnext + 1; } while (0)
  for (int j = 1; j + 1 < NT; j += 2) {
    SDMA((j + 1) * 64, 0, vnext);
    qkt64(pB0, pB1, K_lds + SHM_K, qr, negm, comp, r32, hi);
    finishSM(pA0, pA1, alA, l_reg, pa0, pa1, pa2, pa3);
    pv_all(o, vb0 + vprev * SHM_V, pa0, pa1, pa2, pa3);
    partialSM(pB0, pB1, m_reg, negm, alB);
    RESCALE(alB);
    SLAND(); VROT(); __syncthreads();
    if (j + 2 < NT) SDMA((j + 2) * 64, 1, vnext);
    qkt64(pA0, pA1, K_lds, qr, negm, comp, r32, hi);
    finishSM(pB0, pB1, alB, l_reg, pa0, pa1, pa2, pa3);
    pv_all(o, vb0 + vprev * SHM_V, pa0, pa1, pa2, pa3);
    partialSM(pA0, pA1, m_reg, negm, alA);
    RESCALE(alA);
    SLAND(); VROT(); __syncthreads();
  }
  qkt64(pB0, pB1, K_lds + SHM_K, qr, negm, comp, r32, hi);
  finishSM(pA0, pA1, alA, l_reg, pa0, pa1, pa2, pa3);
  pv_all(o, vb0 + vprev * SHM_V, pa0, pa1, pa2, pa3);
  partialSM(pB0, pB1, m_reg, negm, alB);
  RESCALE(alB);
  VROT();
  finishSM(pB0, pB1, alB, l_reg, pa0, pa1, pa2, pa3);
  pv_all(o, vb0 + vprev * SHM_V, pa0, pa1, pa2, pa3);
  __syncthreads();
#undef VROT
  if (hi == 0) li_l[r32] = l_reg; LDS_WAIT();
  float rli[16];
#pragma unroll
  for (int r = 0; r < 16; ++r) rli[r] = __builtin_amdgcn_rcpf(li_l[crow(r, hi)]);
  float* X = (float*)(lds + ATT_X) + rb * 4096;
  if (comp == 1) {
#pragma unroll
    for (int r = 0; r < 16; ++r)
#pragma unroll
      for (int d0 = 0; d0 < 4; ++d0) X[crow(r, hi) * 128 + d0 * 32 + r32] = lam * o[d0][r] * rli[r];
  }
  __syncthreads();
  if (comp == 0) {
    float sw[4];
#pragma unroll
    for (int d0 = 0; d0 < 4; ++d0) sw[d0] = subw[d0 * 32 + r32] * 0.8f;
    u16* Ow = Ob + (size_t)(rb * 32) * LDK;
#pragma unroll
    for (int r = 0; r < 16; ++r) { const int orow = crow(r, hi); float ss = 0.f; float v[4];
#pragma unroll
      for (int d0 = 0; d0 < 4; ++d0) { v[d0] = o[d0][r] * rli[r] - X[orow * 128 + d0 * 32 + r32]; ss += v[d0] * v[d0]; }
#pragma unroll
      for (int of = 1; of < 32; of <<= 1) ss += __shfl_xor(ss, of);
      const float rs = rsqrtf(ss * (1.f / 128.f) + EPS);
#pragma unroll
      for (int d0 = 0; d0 < 4; ++d0) Ow[(size_t)orow * LDK + d0 * 32 + r32] = f2bf(v[d0] * rs * sw[d0]); }
  }
  __syncthreads();
#undef SDMA
#undef SLAND
#undef RESCALE
}

constexpr int SC_QP = 0, SC_KP = 16384, SC_QT = 32768, SC_KH = 49152, SC_VV = 65536, SC_SS = 81920, SC_TOT = 114688, SC_BEND = 118784;
template <int VAR> DI void scan_item(int b, int h, int dir, const u16* __restrict__ KKb, const u16* __restrict__ RI, const u16* __restrict__ RQ, u16* __restrict__ OUT, char* lds) {
  int tid_ = threadIdx.x; asm volatile("" : "+v"(tid_)); const int tid = tid_, wid = __builtin_amdgcn_readfirstlane(tid >> 6), lane = tid & 63, r32 = lane & 31, hi = lane >> 5;
  const int k0 = 2 * lane, seg = wid;
  const int tb = wid >> 2, vb = wid & 3, kb0 = 2 * (wid >> 2);
  const int colh = h * 128;
  float* TOT = (float*)(lds + SC_TOT); float* BEND = (float*)(lds + SC_BEND);
  const int lbase = (int)(uintptr_t)lds;
  const int rdb = v_rd_base(lane);
  f32x16 s0 = {}, s1 = {};
  { u32x4v z = {0u, 0u, 0u, 0u}; *(u32x4v*)(lds + SC_SS + tid * 64) = z; *(u32x4v*)(lds + SC_SS + tid * 64 + 16) = z; *(u32x4v*)(lds + SC_SS + tid * 64 + 32) = z; *(u32x4v*)(lds + SC_SS + tid * 64 + 48) = z; }
  const int sr = tid >> 4, sc = (tid & 15) * 8;
  unsigned gr[8], qv[8]; s16x8 vr0, vr1;
#define SC_LOAD(step_) do { const int st_ = (step_); const bool cx_ = st_ < 4; const int c_ = cx_ ? st_ : st_ - 4; \
    const int ch_ = dir ? (cx_ ? 3 - c_ : 31 - c_) : c_; const unsigned kvb_ = (unsigned)(b * TKV + (cx_ ? SEQ : 0) + ch_ * 64); const unsigned ltb_ = (unsigned)(b * SEQ + ch_ * 64); \
    _Pragma("unroll") for (int j = 0; j < 8; ++j) { const int i_ = 8 * seg + j, tk_ = dir ? 63 - i_ : i_; gr[j] = *(const unsigned*)(KKb + (unsigned)((kvb_ + tk_) * 1024u + colh + k0)); \
      if (!cx_) qv[j] = *(const unsigned*)(RQ + (unsigned)((ltb_ + tk_) * 1024u + colh + k0)); } \
    { const int t0_ = dir ? 63 - sr : sr, t1_ = dir ? 31 - sr : 32 + sr; vr0 = *(const s16x8*)(RI + (unsigned)((kvb_ + t0_) * 1024u + colh + sc)); vr1 = *(const s16x8*)(RI + (unsigned)((kvb_ + t1_) * 1024u + colh + sc)); } } while (0)
  SC_LOAD(0);
  for (int step = 0; step < 36; ++step) {
    const bool isctx = step < 4; const int c = isctx ? step : step - 4;
    const int chunk = dir ? (isctx ? 3 - c : 31 - c) : c;
    const unsigned latbase = (unsigned)(b * SEQ + chunk * 64);
    f32x2 kk[8], q[8], P[8];
#pragma unroll
    for (int j = 0; j < 8; ++j) { kk[j] = (f32x2){1.f - fexp(h2f((u16)(gr[j] & 0xffffu))), 1.f - fexp(h2f((u16)(gr[j] >> 16)))}; q[j] = isctx ? (f32x2){0.f, 0.f} : (f32x2){bflo(qv[j]), bfhi(qv[j])}; }
    { f32x2 a = {1.f, 1.f};
#pragma unroll
      for (int j = 0; j < 8; ++j) { a = a * (1.f - kk[j]); P[j] = a; }
      *(f32x2*)(TOT + seg * 128 + k0) = a; }
    const s16x8 cv0 = vr0, cv1 = vr1;
    __syncthreads();
    if (step + 1 < 36) SC_LOAD(step + 1);
    if (VAR != 2 && VAR != 3) { f32x2 pre = {1.f, 1.f}, suf = {1.f, 1.f}, mid = {1.f, 1.f};
#pragma unroll
      for (int s_ = 0; s_ < 8; ++s_) { const f32x2 t = *(const f32x2*)(TOT + s_ * 128 + k0);
        if (s_ < seg) pre = pre * t;
        if (s_ > seg) suf = suf * t;
        if (seg <= 3 ? (s_ > seg && s_ <= 3) : (s_ >= 4 && s_ < seg)) mid = mid * t; }
      if (seg == 7) *(f32x2*)(BEND + k0) = pre * P[7];
      f32x2 sl = {1.f, 1.f};
#pragma unroll
      for (int j = 7; j >= 0; --j) { const int i = 8 * seg + j;
        const f32x2 khat = kk[j] * (sl * suf);
        *(unsigned*)(lds + SC_KH + v_st(i, k0)) = cvtpk(khat.x, khat.y);
        if (!isctx) {
          const f32x2 qt = q[j] * (pre * P[j]);
          f32x2 e1, e2;
          if (seg <= 3) { e2 = sl * mid; e1.x = __builtin_amdgcn_rcpf(fmaxf(e2.x, 1e-30f)); e1.y = __builtin_amdgcn_rcpf(fmaxf(e2.y, 1e-30f)); }
          else { e1 = mid * P[j]; e2.x = __builtin_amdgcn_rcpf(fmaxf(e1.x, 1e-30f)); e2.y = __builtin_amdgcn_rcpf(fmaxf(e1.y, 1e-30f)); }
          const f32x2 qp = q[j] * e1, kp = kk[j] * e2;
          const int o2 = KSWZ(i, k0 * 2);
          *(unsigned*)(lds + SC_QT + o2) = cvtpk(qt.x, qt.y); *(unsigned*)(lds + SC_QP + o2) = cvtpk(qp.x, qp.y); *(unsigned*)(lds + SC_KP + o2) = cvtpk(kp.x, kp.y); }
        sl = sl * (1.f - kk[j]); }
      *(s16x8*)(lds + SC_VV + v_st(sr, sc)) = cv0; *(s16x8*)(lds + SC_VV + v_st(32 + sr, sc)) = cv1; }
    __syncthreads();
    if (VAR != 1 && VAR != 3) {
    if (!isctx) {
      f32x16 p0 = {}, p1 = {};
      const int trow = tb * 32 + r32;
#pragma unroll
      for (int ks = 0; ks < 8; ++ks) { const int cb = (ks * 16 + hi * 8) * 2;
        const s16x8 qf = *(const s16x8*)(lds + SC_QP + KSWZ(trow, cb));
        const s16x8 kf0 = *(const s16x8*)(lds + SC_KP + KSWZ(r32, cb));
        p0 = MFMA32(kf0, qf, p0);
        if (tb == 1) { const s16x8 kf1 = *(const s16x8*)(lds + SC_KP + KSWZ(32 + r32, cb)); p1 = MFMA32(kf1, qf, p1); } }
      { int dd = r32 - 4 * hi; asm volatile("" : "+v"(dd));
        if (tb == 0) {
#pragma unroll
          for (int r = 0; r < 16; ++r) { if ((r & 3) + 8 * (r >> 2) > dd) p0[r] = 0.f; p1[r] = 0.f; }
        } else {
#pragma unroll
          for (int r = 0; r < 16; ++r) { if ((r & 3) + 8 * (r >> 2) > dd) p1[r] = 0.f; }
        } }
      s16x8 pa0, pa1, pa2, pa3;
      PK4(p0, 0, pa0); PK4(p0, 8, pa1); PK4(p1, 0, pa2); PK4(p1, 8, pa3);
      f32x16 o = {};
      pv_blk(o, lbase + SC_VV + rdb + vb * 512, pa0, pa1, pa2, pa3);
#pragma unroll
      for (int ks = 0; ks < 8; ++ks) { const int cb = (ks * 16 + hi * 8) * 2;
        const s16x8 qa = *(const s16x8*)(lds + SC_QT + KSWZ(trow, cb));
        const s16x8 sb = *(const s16x8*)(lds + SC_SS + KSWZ(vb * 32 + r32, cb));
        o = MFMA32(qa, sb, o); }
#pragma unroll
      for (int r = 0; r < 16; ++r) { const int t = tb * 32 + crow(r, hi), tk = dir ? 63 - t : t;
        OUT[(unsigned)((VAR ? ((latbase + tk) & 1023u) : (latbase + tk)) * 1024u + colh + vb * 32 + r32)] = f2bf(o[r]); }
    }
#pragma unroll
    for (int g = 0; g < 4; ++g) { const f32x4v d0 = *(const f32x4v*)(BEND + kb0 * 32 + 8 * g + 4 * hi), d1 = *(const f32x4v*)(BEND + kb0 * 32 + 32 + 8 * g + 4 * hi);
#pragma unroll
      for (int i = 0; i < 4; ++i) { s0[4 * g + i] *= d0[i]; s1[4 * g + i] *= d1[i]; } }
    tt_blk(s0, lbase + SC_KH + rdb + kb0 * 512, lbase + SC_VV + rdb + vb * 512);
    tt_blk(s1, lbase + SC_KH + rdb + (kb0 + 1) * 512, lbase + SC_VV + rdb + vb * 512);
    }
    __syncthreads();
#pragma unroll
    for (int g = 0; g < 4; ++g) { const int vrow = vb * 32 + r32, kc0 = (kb0 * 32 + 8 * g + 4 * hi) * 2, kc1 = kc0 + 64;
      u32x2v w0 = {cvtpk(s0[4 * g], s0[4 * g + 1]), cvtpk(s0[4 * g + 2], s0[4 * g + 3])}, w1 = {cvtpk(s1[4 * g], s1[4 * g + 1]), cvtpk(s1[4 * g + 2], s1[4 * g + 3])};
      *(u32x2v*)(lds + SC_SS + KSWZ(vrow, kc0)) = w0; *(u32x2v*)(lds + SC_SS + KSWZ(vrow, kc1)) = w1; }
  }
  __syncthreads();
#undef SC_LOAD
}
#define XB_TMO      128
#define XB_XCNT(j)  (256  + 64 * (j))
#define XB_XSUB(j)  (1280 + 64 * (j))
#define XB_XGEN(j)  (2304 + 64 * (j))
#define XB_TOP      3328
#define XB_TOPGEN   3392
#define XCD_BAR_WORDS 3456
#define XB_SPIN_CAP (1u << 18)

__device__ __forceinline__ unsigned xb_ld(unsigned* p)              { return __hip_atomic_load(p, __ATOMIC_RELAXED, __HIP_MEMORY_SCOPE_AGENT); }
__device__ __forceinline__ unsigned xb_add(unsigned* p, unsigned v) { return __hip_atomic_fetch_add(p, v, __ATOMIC_RELAXED, __HIP_MEMORY_SCOPE_AGENT); }
__device__ __forceinline__ unsigned xb_xcc_id() { return (unsigned)__builtin_amdgcn_s_getreg((3 << 11) | 20) & 0xFu; }
#define XB_SPIN(cond, bar) do { unsigned _sp = 0; while (cond) { __builtin_amdgcn_s_sleep(1); \
    if ((++_sp & 255u) == 0u) { if (xb_ld(&(bar)[XB_TMO])) break; if (_sp > XB_SPIN_CAP) { atomicAdd(&(bar)[XB_TMO], 1u); break; } } } } while (0)

struct XcdBarrier {
    unsigned* bar; unsigned x;
    volatile LAS unsigned* st;
};

__device__ __forceinline__ XcdBarrier xcd_barrier_post(unsigned* bar, volatile LAS unsigned* st) {
    XcdBarrier b; b.bar = bar; b.x = xb_xcc_id(); b.st = st;
    if (threadIdx.x == 0) (void)xb_add(&bar[XB_XCNT(b.x)], 1u);
    return b;
}
__device__ __forceinline__ void xcd_barrier_complete(unsigned* bar, unsigned x, unsigned& nloc, unsigned& nx) {
    const unsigned G = gridDim.x * gridDim.y * gridDim.z;
    unsigned sum, cnt, mine, sp = 0u;
    for (;;) {
        sum = 0u; cnt = 0u; mine = 0u;
#pragma unroll
        for (unsigned j = 0; j < 16; ++j) { const unsigned c = xb_ld(&bar[XB_XCNT(j)]); sum += c; cnt += (c > 0u) ? 1u : 0u; mine = (j == x) ? c : mine; }
        if (sum == G) break;
        __builtin_amdgcn_s_sleep(1);
        if ((++sp & 255u) == 0u) { if (xb_ld(&bar[XB_TMO])) break; if (sp > XB_SPIN_CAP) { atomicAdd(&bar[XB_TMO], 1u); break; } }
    }
    nloc = mine > 0u ? mine : 1u; nx = cnt > 0u ? cnt : 1u;
}

__device__ __forceinline__ void xcd_barrier(const XcdBarrier& b) {
    asm volatile("s_waitcnt vmcnt(0)" ::: "memory");
    __syncthreads();
    if (threadIdx.x == 0) {
        unsigned* bar = b.bar;
        __builtin_amdgcn_s_waitcnt(0);
        unsigned nloc = b.st[0], nx = b.st[1];
        if (nloc == 0u) { xcd_barrier_complete(bar, b.x, nloc, nx); b.st[0] = nloc; b.st[1] = nx; }
        const unsigned old = xb_add(&bar[XB_XSUB(b.x)], 1u);
        const unsigned gen = old / nloc;
        if (old + 1u == (gen + 1u) * nloc) {
            __builtin_amdgcn_fence(__ATOMIC_RELEASE, "agent");
            asm volatile("s_waitcnt vmcnt(0)" ::: "memory");
            const unsigned og = xb_add(&bar[XB_TOP], 1u);
            const unsigned tg = og / nx;
            if (og + 1u == (tg + 1u) * nx) xb_add(&bar[XB_TOPGEN], 1u);
            else XB_SPIN(xb_ld(&bar[XB_TOPGEN]) == tg, bar);
            __builtin_amdgcn_fence(__ATOMIC_ACQUIRE, "agent");
            xb_add(&bar[XB_XGEN(b.x)], 1u);
            asm volatile("s_waitcnt vmcnt(0)" ::: "memory");
        } else {
            XB_SPIN(xb_ld(&bar[XB_XGEN(b.x)]) == gen, bar);
            __builtin_amdgcn_fence(__ATOMIC_ACQUIRE, "agent");
            asm volatile("s_waitcnt vmcnt(0)" ::: "memory");
        }
    }
    __syncthreads();
}

#ifndef DUP_MASK
#define DUP_MASK 0
#endif
#ifndef PHASES
#define PHASES 0xfff
#endif
struct Params {
  const float *x, *c, *ctx, *c_ctx, *w_mod, *b_mod, *norm1_w, *w_in, *lam_q1, *lam_k1, *lam_q2, *lam_k2, *subln_w, *rec_lb, *rec_gnorm_w,
              *w_branch_attn, *w_branch_rec, *w_out, *norm2_w, *w_up, *conv_w, *conv_b, *w_down, *final_norm_w;
  float* out; unsigned char* ws;
};
DI int cperm(int p) { return 16 * ((p >> 2) & 1) + 4 * (p >> 3) + (p & 3); }
DI void transpose_item(const float* __restrict__ W, int K, int N, u16* __restrict__ WT, float* scr, int item, int lane, bool perm, bool pair_up = false) {
  const int nblk = N / 32, kb = item / nblk, nb = item % nblk, k0 = 64 * kb, n0 = 32 * nb;
  const int ns0 = pair_up ? (((n0 & 255) < 128) ? 128 * (n0 >> 8) + (n0 & 255) : FF + 128 * (n0 >> 8) + (n0 & 255) - 128) : n0;
  float tv[32];
#pragma unroll
  for (int i = 0; i < 32; ++i) { const int kk = 2 * i + (lane >> 5); tv[i] = W[(size_t)(k0 + kk) * N + ns0 + (lane & 31)]; }
#pragma unroll
  for (int i = 0; i < 32; ++i) { const int kk = 2 * i + (lane >> 5); scr[kk * 33 + (lane & 31)] = tv[i]; }
  LDS_WAIT(); asm volatile("" ::: "memory");
  const int c = lane & 7;
#pragma unroll
  for (int j = 0; j < 4; ++j) { const int n = (lane >> 3) + 8 * j; const float* s = scr + (8 * c) * 33 + (perm ? cperm(n) : n);
    u32x4v o; o.x = cvtpk(s[0 * 33], s[1 * 33]); o.y = cvtpk(s[2 * 33], s[3 * 33]); o.z = cvtpk(s[4 * 33], s[5 * 33]); o.w = cvtpk(s[6 * 33], s[7 * 33]);
    *(u32x4v*)(WT + (size_t)(n0 + n) * K + k0 + 8 * c) = o; }
  LDS_WAIT(); asm volatile("" ::: "memory");
}
DI void mod_item(const Params& p, float* mod, int item, int lane) {
  const int cb = item % 48, kch = item / 48, c0 = cb * 256 + lane * 4, k0 = kch * 64;
  float sv[9];
#pragma unroll
  for (int r = 0; r < 8; ++r) sv[r] = silu_(p.c[r * DM + k0 + lane]);
  sv[8] = silu_(p.c_ctx[k0 + lane]);
  f32x4v acc[9];
#pragma unroll
  for (int r = 0; r < 9; ++r) acc[r] = (f32x4v){0.f, 0.f, 0.f, 0.f};
  if (kch == 0) { const f32x4v bv = *(const f32x4v*)(p.b_mod + c0);
#pragma unroll
    for (int r = 0; r < 9; ++r) acc[r] = bv; }
#pragma unroll 4
  for (int kk = 0; kk < 64; ++kk) { const f32x4v w = *(const f32x4v*)(p.w_mod + (size_t)(k0 + kk) * NIN + c0);
#pragma unroll
    for (int r = 0; r < 9; ++r) { const float s = __shfl(sv[r], kk); acc[r] += w * s; } }
#pragma unroll
  for (int r = 0; r < 9; ++r)
#pragma unroll
    for (int j = 0; j < 4; ++j) unsafeAtomicAdd(mod + (size_t)r * NIN + c0 + j, acc[r][j]);
}
DI void sincos_small(float a, float& sn, float& cs) {
  const double x = (double)a; const double kq = __builtin_rint(x * 0.63661977236758134308);
  const double r = (x - kq * 1.5707963267948966192) ; const double r2 = r * r;
  double s = r * (1.0 + r2 * (-1.0 / 6 + r2 * (1.0 / 120 + r2 * (-1.0 / 5040 + r2 * (1.0 / 362880 + r2 * (-1.0 / 39916800 + r2 * (1.0 / 6227020800.0)))))));
  double c = 1.0 + r2 * (-0.5 + r2 * (1.0 / 24 + r2 * (-1.0 / 720 + r2 * (1.0 / 40320 + r2 * (-1.0 / 3628800 + r2 * (1.0 / 479001600 + r2 * (-1.0 / 87178291200.0)))))));
  const int q = ((int)kq) & 3;
  const double ss = (q == 0) ? s : (q == 1) ? c : (q == 2) ? -s : -c;
  const double cc = (q == 0) ? c : (q == 1) ? -s : (q == 2) ? -c : s;
  sn = (float)ss; cs = (float)cc;
}
DI void norm_mod_row(const float* __restrict__ xrow, const float* __restrict__ nw, const float* __restrict__ sc, const float* __restrict__ sh, u16* __restrict__ orow, int lane) {
  const f32x4v* xr = (const f32x4v*)xrow + lane; f32x4v v[8]; float s = 0.f;
#pragma unroll
  for (int j = 0; j < 8; ++j) { v[j] = xr[64 * j]; s += (v[j].x * v[j].x + v[j].y * v[j].y) + (v[j].z * v[j].z + v[j].w * v[j].w); }
  const float rstd = rsqrtf(wave_sum(s) * (1.f / DM) + EPS);
#pragma unroll
  for (int j = 0; j < 8; ++j) { const int c = 4 * (lane + 64 * j);
    const f32x4v w = *(const f32x4v*)(nw + c), a = *(const f32x4v*)(sc + c), d = *(const f32x4v*)(sh + c);
    const f32x4v y = v[j] * rstd * w * (1.f + a) + d;
    u32x2v o; o.x = cvtpk(y.x, y.y); o.y = cvtpk(y.z, y.w); *(u32x2v*)(orow + c) = o; }
}

DI void rec_readout_row(const u16* __restrict__ OF, const u16* __restrict__ OB, u16* RG, const float* __restrict__ gnw, int m, int lane) {
    const size_t off = (size_t)m * 1024 + lane * 16;
    const u32x4v a0 = *(const u32x4v*)(OF + off), a1 = *(const u32x4v*)(OF + off + 8), b0 = *(const u32x4v*)(OB + off), b1 = *(const u32x4v*)(OB + off + 8);
    const u32x4v g0 = *(const u32x4v*)(RG + off), g1 = *(const u32x4v*)(RG + off + 8);
    float v[16]; float s = 0.f;
#pragma unroll
    for (int i = 0; i < 4; ++i) { v[2 * i] = bflo(a0[i]) + bflo(b0[i]); v[2 * i + 1] = bfhi(a0[i]) + bfhi(b0[i]); v[8 + 2 * i] = bflo(a1[i]) + bflo(b1[i]); v[8 + 2 * i + 1] = bfhi(a1[i]) + bfhi(b1[i]); }
#pragma unroll
    for (int i = 0; i < 16; ++i) s += v[i] * v[i];
    const float rstd = rsqrtf(wave_sum(s) * (1.f / 1024.f) + EPS);
    const float* gw_ = gnw + lane * 16;
    u32x4v o0, o1;
#pragma unroll
    for (int i = 0; i < 4; ++i) {
      o0[i] = cvtpk(v[2 * i] * rstd * gw_[2 * i] * bflo(g0[i]), v[2 * i + 1] * rstd * gw_[2 * i + 1] * bfhi(g0[i]));
      o1[i] = cvtpk(v[8 + 2 * i] * rstd * gw_[8 + 2 * i] * bflo(g1[i]), v[8 + 2 * i + 1] * rstd * gw_[8 + 2 * i + 1] * bfhi(g1[i])); }
    *(u32x4v*)(RG + off) = o0; *(u32x4v*)(RG + off + 8) = o1;
}
typedef const __attribute__((address_space(4))) Params* KargP;
#if defined(__HIP_DEVICE_COMPILE__)
#define LOAD_PARAMS() KargP kp_ = (KargP)__builtin_amdgcn_kernarg_segment_ptr(); asm volatile("" : "+s"(kp_)); const Params p = *kp_;
#else
#define LOAD_PARAMS() const Params p = p_unused;
#endif
#define PHASE_BEGIN() \
  LOAD_PARAMS() \
  int tid_ = threadIdx.x; asm volatile("" : "+v"(tid_)); const int tid = tid_, lane = tid & 63, wave = __builtin_amdgcn_readfirstlane(tid >> 6); \
  const int G = gridDim.x, bx = blockIdx.x, gw = bx * 8 + wave, NGW = G * 8; (void)gw; (void)NGW; (void)lane; \
  unsigned char* ws = p.ws; float* ctl = (float*)(ws + WS_CTL); float* mod = ctl + C_MOD; (void)mod; \
  char* lds = (char*)lds_raw; (void)lds; pg8::LdsPtr glds = (pg8::LdsPtr)lds_raw; (void)glds;
#define WSP(name, off) u16* name = (u16*)(ws + (off))
__global__ void __launch_bounds__(512, 2) fwd_megakernel(Params p_unused) {
  extern __shared__ __attribute__((aligned(16))) unsigned char lds_raw[];
  cg::grid_group grid = cg::this_grid();
  { volatile LAS unsigned* st_ = (volatile LAS unsigned*)((LAS unsigned char*)lds_raw + XB_LDS_OFF);
    if (threadIdx.x < 2) st_[threadIdx.x] = 0u;
    __syncthreads();
    LOAD_PARAMS()
    (void)xcd_barrier_post((unsigned*)(p.ws + WS_CTL) + C_BAR, st_); }
#define FAST_SYNC() do { LOAD_PARAMS() XcdBarrier xb_; xb_.bar = (unsigned*)(p.ws + WS_CTL) + C_BAR; xb_.x = xb_xcc_id(); \
    xb_.st = (volatile LAS unsigned*)((LAS unsigned char*)lds_raw + XB_LDS_OFF); xcd_barrier(xb_); } while (0)
  _Pragma("unroll") for (int rep = 0; rep <= ((DUP_MASK >> 0) & 1); ++rep) {
  if (PHASES & (1 << 0)) {
  PHASE_BEGIN() WSP(WUP, WS_WUP); WSP(WDN, WS_WDN); WSP(WIN, WS_WIN); WSP(WBA, WS_WBA); WSP(WBR, WS_WBR); WSP(WOUT, WS_WOUT);
  {
    float* scr = (float*)(lds + wave * 16384);
    constexpr int I_IN = 32 * 384;
    constexpr int NITEMS = I_IN;
    if (rep == 0 && gw < 1536) mod_item(p, mod, gw, lane);
    for (int it = gw; it < NITEMS; it += NGW) {
      int r = it;
      { const int nb = r % 384; transpose_item(p.w_in, DM, NIN, WIN, scr, r, lane, (nb < 32) || (nb >= 160 && nb < 192)); }
    }
    if (bx == G - 1) {
      if (wave == 0) { const float a = wave_sum(p.lam_q1[lane] * p.lam_k1[lane]), bq = wave_sum(p.lam_q2[lane] * p.lam_k2[lane]);
        if (lane == 0) ctl[C_LAM] = __expf(a) - __expf(bq) + 0.2f; }
      for (int k = tid; k < 1024; k += 512) { ctl[C_LBF + k] = sigm(p.rec_lb[k] - p.rec_lb[1024 + k]); ctl[C_LBB + k] = sigm(p.rec_lb[2048 + k] - p.rec_lb[3072 + k]); }
    }
    if (bx == G - 2) {
      for (int e = tid; e < 1024; e += 512) { const int pos = e >> 4, j = e & 15; const float iv = __builtin_amdgcn_exp2f(-(float)j * 0.83048202372184058696f);
        float sn, cs; sincos_small((float)pos * iv, sn, cs); ctl[C_COS + e] = cs; ctl[C_SIN + e] = sn; }
    }
  }
  }
  FAST_SYNC();
  if (gridDim.x == 0x7fffffffu) grid.sync();
  }
  _Pragma("unroll") for (int rep = 0; rep <= ((DUP_MASK >> 1) & 1); ++rep) {
  if (PHASES & (1 << 1)) {
  PHASE_BEGIN() WSP(H, WS_H);
  for (int m = gw; m < MALL; m += NGW) {
    if (m < MTOK) { const float* mr = mod + (size_t)(m >> 11) * NIN; norm_mod_row(p.x + (size_t)m * DM, p.norm1_w, mr + 2048, mr, H + (size_t)m * DM, lane); }
    else { const float* mr = mod + (size_t)8 * NIN; norm_mod_row(p.ctx + (size_t)(m - MTOK) * DM, p.norm1_w, mr + 2048, mr, H + (size_t)m * DM, lane); }
  }
  }
  FAST_SYNC();
  }
  _Pragma("unroll") for (int rep = 0; rep <= ((DUP_MASK >> 2) & 1); ++rep) {
  if (PHASES & (1 << 2)) {
  PHASE_BEGIN() WSP(H, WS_H); WSP(WIN, WS_WIN); WSP(AK, WS_AK); WSP(AV, WS_AV); WSP(LFF, WS_LFF); WSP(LFB, WS_LFB); WSP(RI, WS_RI); WSP(RQ, WS_RQ); WSP(AQ, WS_AQ); WSP(RG, WS_RG); u16* GATES = (u16*)p.out;
  {
    pg8::Gemm g{H, WIN, MALL, NIN, DM, DM}; pg8::OrderIn S; S.init(G, bx);
    pg8::EpiIn E{AK, AV, LFF, LFB, RI, AQ, RQ, RG, GATES, ctl + C_LBF, ctl + C_LBB, ctl + C_COS, ctl + C_SIN};
#ifdef PROBE_EPINONE
    if (rep == 1) { pg8::EpiNone EN{(float*)(ws + WS_CTL) + 200000}; pg8::gemm_phase<pg8::EpiNone, pg8::OrderIn, true, true>(glds, g, S, EN); } else
#endif
    pg8::gemm_phase<pg8::EpiIn, pg8::OrderIn, true, true>(glds, g, S, E);
    const int tf_ = (G > 160) ? 160 : 0;
    if (bx >= tf_) {
      __syncthreads();
      float* scr = (float*)(lds + wave * 16384);
      constexpr int I_BA = 16 * 64, I_OUT = 32 * 64, I_DN = 88 * 64, NIT2 = 2 * I_BA + I_OUT + I_DN;
      WSP(WBA, WS_WBA); WSP(WBR, WS_WBR); WSP(WOUT, WS_WOUT); WSP(WDN, WS_WDN);
      for (int it = (bx - tf_) * 8 + wave; it < NIT2; it += (G - tf_) * 8) {
        int r = it;
        if (r < I_BA) { transpose_item(p.w_branch_attn, 1024, DM, WBA, scr, r, lane, false); continue; } r -= I_BA;
        if (r < I_BA) { transpose_item(p.w_branch_rec, 1024, DM, WBR, scr, r, lane, false); continue; } r -= I_BA;
        if (r < I_OUT) { transpose_item(p.w_out, DM, DM, WOUT, scr, r, lane, false); continue; } r -= I_OUT;
        transpose_item(p.w_down, FF, DM, WDN, scr, r, lane, false);
      }
    }
  }
  }
  FAST_SYNC();
  }
  _Pragma("unroll") for (int rep = 0; rep <= ((DUP_MASK >> 3) & 1); ++rep) {
  if (PHASES & (1 << 3)) {
  PHASE_BEGIN() WSP(AK, WS_AK); WSP(AV, WS_AV); WSP(LFF, WS_LFF); WSP(LFB, WS_LFB); WSP(RI, WS_RI); WSP(RQ, WS_RQ); WSP(AQ, WS_AQ); WSP(ATT, WS_ATT); WSP(OF, WS_OF); WSP(OB, WS_OB); WSP(RG, WS_RG);
  {
#ifndef NO_SCAN
#ifdef PROBE_ATTONLY
    if (rep == 0)
#endif
    if (bx < 128) { const int b = bx >> 4, h = (bx >> 1) & 7, dir = bx & 1;
#ifdef PROBE_SCANVAR
      if (rep == 1) scan_item<PROBE_SCANVAR>(b, h, dir, dir ? LFB : LFF, RI, RQ, (u16*)(ws + 196 * MiB), lds); else
#endif
      scan_item<0>(b, h, dir, dir ? LFB : LFF, RI, RQ, dir ? OB : OF, lds);
      asm volatile("s_waitcnt vmcnt(0)" ::: "memory"); __syncthreads();
      if (tid == 0) { __builtin_amdgcn_fence(__ATOMIC_RELEASE, "agent"); asm volatile("s_waitcnt vmcnt(0)" ::: "memory");
        (void)__hip_atomic_fetch_add((unsigned*)(ctl + C_CTR) + 1024, 1u, __ATOMIC_RELAXED, __HIP_MEMORY_SCOPE_AGENT); } }
#endif
#ifndef NO_ATT
#ifdef PROBE_SCANONLY
    if (rep == 0)
#endif
    {
    const float lam = ctl[C_LAM];
    const unsigned xcc = (unsigned)__builtin_amdgcn_s_getreg((3 << 11) | 20) & 7u;
    for (int qi = 0; qi < 8; ++qi) {
      const unsigned q = (xcc + (unsigned)qi) & 7u;
      unsigned* ctr = (unsigned*)(ctl + C_CTR) + 512 * rep + 32 * q;
      for (;;) {
        if (tid == 0) *(volatile unsigned*)(lds + ATT_CTR) = atomicAdd(ctr, 1u);
        __syncthreads();
        const unsigned u = *(volatile unsigned*)(lds + ATT_CTR);
        __syncthreads();
        if (u >= 128u) break;
        const int b = (int)q, h = (int)(u >> 4), qb = (int)(u & 15u);
#ifdef PROBE_ATTVAR
        if (rep == 1) attn_unit<PROBE_ATTVAR>(AQ + ((size_t)b * SEQ + qb * 128) * 1024 + h * 128, (u16*)(ws + 196 * MiB) + (size_t)(qb & 7) * 128 * 1024 + h * 128, AK + (size_t)b * TKV * 1024 + h * 128, AV + (size_t)b * TKV * 1024 + h * 128, lam, p.subln_w, lds); else
#endif
        attn_unit<0>(AQ + ((size_t)b * SEQ + qb * 128) * 1024 + h * 128, ATT + ((size_t)b * SEQ + qb * 128) * 1024 + h * 128, AK + (size_t)b * TKV * 1024 + h * 128, AV + (size_t)b * TKV * 1024 + h * 128, lam, p.subln_w, lds);
      }
    }
    }
#endif
    { unsigned* sdone = (unsigned*)(ctl + C_CTR) + 1024; unsigned* rq = (unsigned*)(ctl + C_CTR) + 1056;
      if (tid == 0) { unsigned sp = 0u;
        while (__hip_atomic_load(sdone, __ATOMIC_RELAXED, __HIP_MEMORY_SCOPE_AGENT) < 128u) { __builtin_amdgcn_s_sleep(8); if (++sp > (1u << 20)) break; }
        __builtin_amdgcn_fence(__ATOMIC_ACQUIRE, "agent"); asm volatile("s_waitcnt vmcnt(0)" ::: "memory"); }
      __syncthreads();
      for (;;) {
        if (tid == 0) *(volatile unsigned*)(lds + ATT_CTR) = atomicAdd(rq, 1u);
        __syncthreads();
        const unsigned it = *(volatile unsigned*)(lds + ATT_CTR);
        __syncthreads();
        if (it >= 256u) break;
#pragma unroll 1
        for (int i = 0; i < 8; ++i) rec_readout_row(OF, OB, RG, p.rec_gnorm_w, (int)it * 64 + wave * 8 + i, lane);
      }
      unsigned* tq = (unsigned*)(ctl + C_CTR) + 1120; u16* WUP = (u16*)(ws + WS_WUP);
      float* scr = (float*)(lds + wave * 16384);
      for (;;) {
        if (tid == 0) *(volatile unsigned*)(lds + ATT_CTR) = atomicAdd(tq, 1u);
        __syncthreads();
        const unsigned it = *(volatile unsigned*)(lds + ATT_CTR);
        __syncthreads();
        if (it >= 1408u) break;
        transpose_item(p.w_up, DM, FF2, WUP, scr, (int)it * 8 + wave, lane, false, true);
      } }
  }
  }
  FAST_SYNC();
  }
  _Pragma("unroll") for (int rep = 0; rep <= ((DUP_MASK >> 5) & 1); ++rep) {
  if (PHASES & (1 << 5)) {
  PHASE_BEGIN() WSP(ATT, WS_ATT); WSP(RG, WS_RG); WSP(WBA, WS_WBA); WSP(WBR, WS_WBR); WSP(Y, WS_Y); u16* T = (u16*)(ws + WS_T); u16* GATES = (u16*)p.out;
  {
    pg8::StaticOrder S; S.init(MTOK, DM, G, bx);
    { pg8::Gemm g{ATT, WBA, MTOK, DM, 1024, 1024}; pg8::EpiMergeA E{GATES, T}; pg8::gemm_phase<pg8::EpiMergeA, pg8::StaticOrder, true, true>(glds, g, S, E); }
    __syncthreads();
    { pg8::Gemm g{RG, WBR, MTOK, DM, 1024, 1024}; pg8::EpiMergeB E{GATES, T, Y}; pg8::gemm_phase<pg8::EpiMergeB, pg8::StaticOrder, true, true>(glds, g, S, E); }
  }
  }
  FAST_SYNC();
  }
  _Pragma("unroll") for (int rep = 0; rep <= ((DUP_MASK >> 6) & 1); ++rep) {
  if (PHASES & (1 << 6)) {
  PHASE_BEGIN() WSP(Y, WS_Y); WSP(WOUT, WS_WOUT);
  {
    pg8::StaticOrder S; S.init(MTOK, DM, G, bx);
    pg8::Gemm g{Y, WOUT, MTOK, DM, DM, DM}; pg8::EpiRes E{p.x, p.out, mod + 4096};
    pg8::gemm_phase<pg8::EpiRes, pg8::StaticOrder, true, true>(glds, g, S, E);
  }
  }
  FAST_SYNC();
  }
  _Pragma("unroll") for (int rep = 0; rep <= ((DUP_MASK >> 7) & 1); ++rep) {
  if (PHASES & (1 << 7)) {
  PHASE_BEGIN() WSP(H2, WS_H2);
  for (int m = gw; m < MTOK; m += NGW) { const float* mr = mod + (size_t)(m >> 11) * NIN; norm_mod_row(p.out + (size_t)m * DM, p.norm2_w, mr + 8192, mr + 6144, H2 + (size_t)m * DM, lane); }
  }
  FAST_SYNC();
  }
  _Pragma("unroll") for (int rep = 0; rep <= ((DUP_MASK >> 8) & 1); ++rep) {
  if (PHASES & (1 << 8)) {
  PHASE_BEGIN() WSP(H2, WS_H2); WSP(WUP, WS_WUP); WSP(U, WS_U); WSP(SIDE, WS_SIDE);
  {
    pg8::StaticOrder so; so.init(MTOK, FF2, G, bx);
    pg8::Gemm g{H2, WUP, MTOK, FF2, DM, DM}; pg8::EpiConv E{U, SIDE, p.conv_w, p.conv_b};
    pg8::Unit uu;
    for (int i = 0; so.next(i, uu); ++i) { pg8::OneUnit S1{uu}; pg8::gemm_phase<pg8::EpiConv, pg8::OneUnit, false, true>(glds, g, S1, E); }
  }
  }
  FAST_SYNC();
  }
  _Pragma("unroll") for (int rep = 0; rep <= ((DUP_MASK >> 9) & 1); ++rep) {
  if (PHASES & (1 << 9)) {
  PHASE_BEGIN() WSP(U, WS_U); WSP(SIDE, WS_SIDE);
  for (int it = gw; it < 64 * 2 * 11; it += NGW) {
    const int pg = it % 11, which = (it / 11) & 1, pm = it / 22;
    const int pn = pg * 4 + (lane >> 4), c8 = lane & 15, f = pn * 128 + c8 * 8;
    const bool edge = which == 0 ? ((pm & 7) == 0) : ((pm & 7) == 7);
    float wa[3][8], wb[3][8], ba[8], bb[8];
#pragma unroll
    for (int j = 0; j < 3; ++j)
#pragma unroll
      for (int i = 0; i < 8; ++i) { wa[j][i] = p.conv_w[j * FF2 + f + i]; wb[j][i] = p.conv_w[j * FF2 + FF + f + i]; }
#pragma unroll
    for (int i = 0; i < 8; ++i) { ba[i] = p.conv_b[f + i]; bb[i] = p.conv_b[FF + f + i]; }
    const u32x4v z = {0u, 0u, 0u, 0u};
    const u16* s_own = SIDE + ((size_t)(pm * 44 + pn) * 4) * 256;
    u32x4v pa, pb, ca, cb, na, nb;
    if (which == 0) {
      if (edge) { pa = z; pb = z; } else { const u16* sp = SIDE + ((size_t)((pm - 1) * 44 + pn) * 4 + 3) * 256; pa = *(const u32x4v*)(sp + c8 * 8); pb = *(const u32x4v*)(sp + 128 + c8 * 8); }
      ca = *(const u32x4v*)(s_own + c8 * 8); cb = *(const u32x4v*)(s_own + 128 + c8 * 8);
      na = *(const u32x4v*)(s_own + 256 + c8 * 8); nb = *(const u32x4v*)(s_own + 256 + 128 + c8 * 8);
    } else {
      pa = *(const u32x4v*)(s_own + 512 + c8 * 8); pb = *(const u32x4v*)(s_own + 512 + 128 + c8 * 8);
      ca = *(const u32x4v*)(s_own + 768 + c8 * 8); cb = *(const u32x4v*)(s_own + 768 + 128 + c8 * 8);
      if (edge) { na = z; nb = z; } else { const u16* sp = SIDE + ((size_t)((pm + 1) * 44 + pn) * 4 + 0) * 256; na = *(const u32x4v*)(sp + c8 * 8); nb = *(const u32x4v*)(sp + 128 + c8 * 8); }
    }
    u32x4v o;
#pragma unroll
    for (int i = 0; i < 4; ++i) {
      const float a0 = ba[2 * i] + wa[0][2 * i] * bflo(pa[i]) + wa[1][2 * i] * bflo(ca[i]) + wa[2][2 * i] * bflo(na[i]);
      const float a1 = ba[2 * i + 1] + wa[0][2 * i + 1] * bfhi(pa[i]) + wa[1][2 * i + 1] * bfhi(ca[i]) + wa[2][2 * i + 1] * bfhi(na[i]);
      const float b0 = bb[2 * i] + wb[0][2 * i] * bflo(pb[i]) + wb[1][2 * i] * bflo(cb[i]) + wb[2][2 * i] * bflo(nb[i]);
      const float b1 = bb[2 * i + 1] + wb[0][2 * i + 1] * bfhi(pb[i]) + wb[1][2 * i + 1] * bfhi(cb[i]) + wb[2][2 * i + 1] * bfhi(nb[i]);
      o[i] = cvtpk(silu_(a0) * b0, silu_(a1) * b1); }
    *(u32x4v*)(U + (size_t)(pm * 256 + (which ? 255 : 0)) * FF + f) = o;
  }
  }
  FAST_SYNC();
  }
  _Pragma("unroll") for (int rep = 0; rep <= ((DUP_MASK >> 10) & 1); ++rep) {
  if (PHASES & (1 << 10)) {
  PHASE_BEGIN() WSP(U, WS_U); WSP(WDN, WS_WDN);
  {
    pg8::StaticOrder S; S.init(MTOK, DM, G, bx);
    pg8::Gemm g{U, WDN, MTOK, DM, FF, FF}; pg8::EpiRes E{p.out, p.out, mod + 10240};
    pg8::gemm_phase<pg8::EpiRes, pg8::StaticOrder, true, true>(glds, g, S, E);
  }
  }
  FAST_SYNC();
  }
  _Pragma("unroll") for (int rep = 0; rep <= ((DUP_MASK >> 11) & 1); ++rep) {
  if (PHASES & (1 << 11)) {
  PHASE_BEGIN()
  for (int m = gw; m < MTOK; m += NGW) {
    f32x4v* xr = (f32x4v*)(p.out + (size_t)m * DM) + lane; f32x4v v[8]; float s = 0.f;
#pragma unroll
    for (int j = 0; j < 8; ++j) { v[j] = xr[64 * j]; s += (v[j].x * v[j].x + v[j].y * v[j].y) + (v[j].z * v[j].z + v[j].w * v[j].w); }
    const float rstd = rsqrtf(wave_sum(s) * (1.f / DM) + EPS);
#pragma unroll
    for (int j = 0; j < 8; ++j) { const f32x4v w = *(const f32x4v*)(p.final_norm_w + 4 * (lane + 64 * j)); xr[64 * j] = v[j] * rstd * w; }
  }
  }
  }
}

extern "C" void kernel_launch(void* const* d_in, const int* in_sizes, int n_in, void* d_out, int out_size, void* d_ws, size_t ws_size, hipStream_t stream) {
  static int grid = 0;
  if (grid == 0) {
    if (n_in != 24 || in_sizes[0] != MTOK * DM || out_size != MTOK * DM || ws_size < WS_END) {
      fprintf(stderr, "kernel_launch: unexpected shapes: n_in %d in0 %d out %d ws %zu (need >= %zu)\n", n_in, n_in > 0 ? in_sizes[0] : -1, out_size, ws_size, (size_t)WS_END); grid = -1; return; }
    int dev = 0, cus = 0, per_cu = 0;
    if (hipGetDevice(&dev) != hipSuccess || hipDeviceGetAttribute(&cus, hipDeviceAttributeMultiprocessorCount, dev) != hipSuccess) { grid = -1; return; }
    if (hipFuncSetAttribute((const void*)fwd_megakernel, hipFuncAttributeMaxDynamicSharedMemorySize, LDS_BYTES) != hipSuccess) { fprintf(stderr, "kernel_launch: hipFuncSetAttribute failed\n"); grid = -1; return; }
    if (hipOccupancyMaxActiveBlocksPerMultiprocessor(&per_cu, (const void*)fwd_megakernel, 512, LDS_BYTES) != hipSuccess || per_cu < 1) { fprintf(stderr, "kernel_launch: occupancy query says %d\n", per_cu); }
    (void)hipGetLastError();
    grid = cus;
    if (grid != 256) fprintf(stderr, "kernel_launch: note: %d CUs\n", grid);
  }
  if (grid < 0) return;
  (void)hipMemsetAsync((char*)d_ws + WS_CTL, 0, CTL_ZERO_BYTES, stream);
  Params p{};
  const float** pp = (const float**)&p;
  for (int i = 0; i < 24; ++i) pp[i] = (const float*)d_in[i];
  p.out = (float*)d_out; p.ws = (unsigned char*)d_ws;
  void* args[] = {&p};
  hipError_t e = hipLaunchCooperativeKernel((const void*)fwd_megakernel, dim3(grid), dim3(512), args, LDS_BYTES, stream);
  if (e != hipSuccess) fprintf(stderr, "kernel_launch: cooperative launch failed: %s (grid %d)\n", hipGetErrorString(e), grid);
}
```
